# Optimizing an MI355X kernel written in HIP

```python
import math
import jax, jax.numpy as jnp
from jax import lax
import numpy as np

D_MODEL = 2048
BATCH = 4
SEQ = 2048
DEPTH = 2

N_MIXERS = 2
ATTN_HEAD_DIM = 64
ATTN_Q_HEADS = D_MODEL // ATTN_HEAD_DIM
ATTN_KV_HEADS = 8
ATTN_GROUP = ATTN_Q_HEADS // ATTN_KV_HEADS
WINDOW = 128
ATTN_BLOCK = 128
ROPE_THETA = 10000.0
ATTN_QKV_W = (ATTN_Q_HEADS + 2 * ATTN_KV_HEADS) * ATTN_HEAD_DIM
MLSTM_HEADS = 4
MLSTM_DV = D_MODEL // MLSTM_HEADS
MLSTM_DK = MLSTM_DV // 2
MLSTM_CHUNK = 64
MLSTM_QK_W = MLSTM_HEADS * MLSTM_DK
MLSTM_V_W = MLSTM_HEADS * MLSTM_DV
MLSTM_IN_W = 2 * MLSTM_QK_W + 2 * MLSTM_V_W + 4 * MLSTM_HEADS
D_FF = 4 * D_MODEL
DEEPNORM_ALPHA = (2.0 * DEPTH) ** 0.25
DEEPNORM_BETA = (8.0 * DEPTH) ** -0.25
LN_EPS = 1e-5
HEAD_NORM_EPS = 1e-6

kernel_name = 'hybrid_swa_sink_mlstm_deepnorm_adaln'


def layer_norm(x, g, b):
    xf = x.astype(jnp.float32)
    mu = jnp.mean(xf, axis=-1, keepdims=True)
    var = jnp.mean(jnp.square(xf - mu), axis=-1, keepdims=True)
    y = (xf - mu) * lax.rsqrt(var + LN_EPS)
    return (y * g.astype(jnp.float32) + b.astype(jnp.float32)).astype(x.dtype)


def rope_cos_sin(positions):
    inv_freq = 1.0 / (ROPE_THETA ** (jnp.arange(0, ATTN_HEAD_DIM, 2, dtype=jnp.float32) / ATTN_HEAD_DIM))
    ang = positions.astype(jnp.float32)[..., None] * inv_freq
    ang = jnp.concatenate([ang, ang], axis=-1)
    return jnp.cos(ang), jnp.sin(ang)


def apply_rope(t, cos, sin):
    t1, t2 = jnp.split(t, 2, axis=-1)
    rot = jnp.concatenate([-t2, t1], axis=-1)
    return (t * cos + rot * sin).astype(t.dtype)


def windowed_gqa_sink(h, positions, w_qkv, b_qkv, sink, w_o, b_o):
    B, S, _ = h.shape
    nb = S // ATTN_BLOCK
    proj = h @ w_qkv + b_qkv
    q, k, v = jnp.split(proj, [ATTN_Q_HEADS * ATTN_HEAD_DIM,
                               (ATTN_Q_HEADS + ATTN_KV_HEADS) * ATTN_HEAD_DIM], axis=-1)
    q = q.reshape(B, S, ATTN_KV_HEADS, ATTN_GROUP, ATTN_HEAD_DIM)
    k = k.reshape(B, S, ATTN_KV_HEADS, ATTN_HEAD_DIM)
    v = v.reshape(B, S, ATTN_KV_HEADS, ATTN_HEAD_DIM)
    cos, sin = rope_cos_sin(positions)
    q = apply_rope(q, cos[:, :, None, None, :], sin[:, :, None, None, :])
    k = apply_rope(k, cos[:, :, None, :], sin[:, :, None, :])
    qb = q.reshape(B, nb, ATTN_BLOCK, ATTN_KV_HEADS, ATTN_GROUP, ATTN_HEAD_DIM)
    pad = ((0, 0), (ATTN_BLOCK, ATTN_BLOCK), (0, 0), (0, 0))
    kp = jnp.pad(k, pad).reshape(B, nb + 2, ATTN_BLOCK, ATTN_KV_HEADS, ATTN_HEAD_DIM)
    vp = jnp.pad(v, pad).reshape(B, nb + 2, ATTN_BLOCK, ATTN_KV_HEADS, ATTN_HEAD_DIM)
    kw = jnp.concatenate([kp[:, :-2], kp[:, 1:-1], kp[:, 2:]], axis=2)
    vw = jnp.concatenate([vp[:, :-2], vp[:, 1:-1], vp[:, 2:]], axis=2)
    s = jnp.einsum('bnqhgd,bnkhd->bnhgqk', qb, kw).astype(jnp.float32) * (ATTN_HEAD_DIM ** -0.5)
    blk = jnp.arange(nb)[:, None, None] * ATTN_BLOCK
    qpos = blk + jnp.arange(ATTN_BLOCK)[None, :, None]
    kpos = blk - ATTN_BLOCK + jnp.arange(3 * ATTN_BLOCK)[None, None, :]
    valid = (jnp.abs(kpos - qpos) <= WINDOW) & (kpos >= 0) & (kpos < S)
    s = jnp.where(valid[None, :, None, None], s, -jnp.inf)
    sk = sink.astype(jnp.float32).reshape(1, 1, ATTN_KV_HEADS, ATTN_GROUP, 1, 1)
    m = jnp.maximum(jnp.max(s, axis=-1, keepdims=True), sk)
    p = jnp.exp(s - m)
    p = p / (jnp.sum(p, axis=-1, keepdims=True) + jnp.exp(sk - m))
    o = jnp.einsum('bnhgqk,bnkhd->bnqhgd', p.astype(vw.dtype), vw)
    o = o.reshape(B, S, ATTN_Q_HEADS * ATTN_HEAD_DIM)
    return o @ w_o + b_o


def mlstm_chunkwise(q, k, v, log_i, log_f):
    Z, S, H, _ = q.shape
    L = MLSTM_CHUNK
    nc = S // L
    def to_chunks(t):
        t = t.reshape((Z, nc, L) + t.shape[2:])
        return jnp.moveaxis(jnp.swapaxes(t, 2, 3), 1, 0)
    qc, kc, vc = to_chunks(q), to_chunks(k), to_chunks(v)
    lic, lfc = to_chunks(log_i), to_chunks(log_f)
    tril = jnp.tril(jnp.ones((L, L), dtype=bool))

    def body(carry, inp):
        C, n, m = carry
        qq, kk, vv, li, lf = inp
        g = jnp.cumsum(lf, axis=-1)
        G = g[..., -1]
        a = g + m[..., None]
        Dm = g[..., :, None] - g[..., None, :] + li[..., None, :]
        Dm = jnp.where(tril, Dm, -jnp.inf)
        m_t = jnp.maximum(a, jnp.max(Dm, axis=-1))
        ea = jnp.exp(a - m_t)
        sc = jnp.einsum('zhtd,zhsd->zhts', qq, kk) * jnp.exp(Dm - m_t[..., None])
        num = ea[..., None] * jnp.einsum('zhtd,zhdv->zhtv', qq, C) + jnp.einsum('zhts,zhsv->zhtv', sc, vv)
        den = ea * jnp.einsum('zhtd,zhd->zht', qq, n) + jnp.sum(sc, axis=-1)
        hh = num / jnp.maximum(jnp.abs(den), jnp.exp(-m_t))[..., None]
        w_log = G[..., None] - g + li
        m_new = jnp.maximum(G + m, jnp.max(w_log, axis=-1))
        decay = jnp.exp(G + m - m_new)
        w = jnp.exp(w_log - m_new[..., None])
        C_new = decay[..., None, None] * C + jnp.einsum('zhs,zhsd,zhsv->zhdv', w, kk, vv)
        n_new = decay[..., None] * n + jnp.einsum('zhs,zhsd->zhd', w, kk)
        return (C_new, n_new, m_new), hh

    init = (jnp.zeros((Z, H, MLSTM_DK, MLSTM_DV), jnp.float32),
            jnp.zeros((Z, H, MLSTM_DK), jnp.float32),
            jnp.full((Z, H), -1e30, jnp.float32))
    _, hs = lax.scan(body, init, (qc, kc, vc, lic, lfc))
    hs = jnp.swapaxes(jnp.moveaxis(hs, 0, 1), 2, 3)
    return hs.reshape(Z, S, H, MLSTM_DV)


def bidir_mlstm(h, w_in, b_in, norm_w, w_o, b_o):
    B, S, _ = h.shape
    proj = h @ w_in + b_in
    q, k, v, o, gates = jnp.split(proj, [MLSTM_QK_W, 2 * MLSTM_QK_W, 2 * MLSTM_QK_W + MLSTM_V_W,
                                         2 * MLSTM_QK_W + 2 * MLSTM_V_W], axis=-1)
    f32 = jnp.float32
    q = q.astype(f32).reshape(B, S, MLSTM_HEADS, MLSTM_DK) * (MLSTM_DK ** -0.5)
    k = k.astype(f32).reshape(B, S, MLSTM_HEADS, MLSTM_DK)
    v = v.astype(f32).reshape(B, S, MLSTM_HEADS, MLSTM_DV)
    gates = gates.astype(f32).reshape(B, S, 4, MLSTM_HEADS)
    both = lambda fw, bw: jnp.concatenate([fw, jnp.flip(bw, axis=1)], axis=0)
    log_i = both(gates[:, :, 0], gates[:, :, 2])
    log_f = jax.nn.log_sigmoid(both(gates[:, :, 1], gates[:, :, 3]))
    hz = mlstm_chunkwise(both(q, q), both(k, k), both(v, v), log_i, log_f)
    hsum = hz[:B] + jnp.flip(hz[B:], axis=1)
    mu = jnp.mean(hsum, axis=-1, keepdims=True)
    var = jnp.mean(jnp.square(hsum - mu), axis=-1, keepdims=True)
    hn = (hsum - mu) * lax.rsqrt(var + HEAD_NORM_EPS)
    hn = hn * norm_w.astype(f32).reshape(MLSTM_HEADS, MLSTM_DV)
    y = jax.nn.sigmoid(o.astype(f32)) * hn.reshape(B, S, MLSTM_V_W)
    return y.astype(h.dtype) @ w_o + b_o


def sq_relu_mlp(h, w1, b1, w2, b2):
    u = jnp.square(jax.nn.relu(h @ w1 + b1))
    return u @ w2 + b2


def setup_inputs(seed: int = 0) -> dict:
    key = jax.random.key(seed)
    ks = jax.random.split(key, 24)
    n_attn = (DEPTH + 1) // N_MIXERS
    n_ml = DEPTH // N_MIXERS
    f32 = jnp.float32
    def w(k, shape, fan_in, gain=1.0):
        return jax.random.normal(k, shape, f32) * (gain * fan_in ** -0.5)
    def small(k, shape, s=0.02):
        return jax.random.normal(k, shape, f32) * s
    x = jax.random.normal(ks[0], (BATCH, SEQ, D_MODEL), f32)
    c = jax.random.normal(ks[1], (BATCH, D_MODEL), f32)
    positions = jnp.broadcast_to(jnp.arange(SEQ, dtype=jnp.int32)[None, :], (BATCH, SEQ))
    attn_w_qkv = w(ks[2], (n_attn, D_MODEL, ATTN_QKV_W), D_MODEL)
    attn_b_qkv = small(ks[3], (n_attn, ATTN_QKV_W))
    attn_sink = jax.random.normal(ks[4], (n_attn, ATTN_Q_HEADS), f32)
    attn_w_o = w(ks[5], (n_attn, ATTN_Q_HEADS * ATTN_HEAD_DIM, D_MODEL), ATTN_Q_HEADS * ATTN_HEAD_DIM, DEEPNORM_BETA)
    attn_b_o = small(ks[6], (n_attn, D_MODEL))
    mlstm_w_in = w(ks[7], (n_ml, D_MODEL, MLSTM_IN_W), D_MODEL)
    f_bias = jnp.linspace(3.0, 6.0, MLSTM_HEADS, dtype=f32)
    gate_bias = jnp.zeros((4, MLSTM_HEADS), f32).at[1].set(f_bias).at[3].set(f_bias)
    base_bias = jnp.concatenate([jnp.zeros((MLSTM_IN_W - 4 * MLSTM_HEADS,), f32), gate_bias.reshape(-1)])
    mlstm_b_in = small(ks[8], (n_ml, MLSTM_IN_W), 0.1) + base_bias
    mlstm_norm_w = 1.0 + small(ks[9], (n_ml, MLSTM_V_W))
    mlstm_w_o = w(ks[10], (n_ml, MLSTM_V_W, D_MODEL), MLSTM_V_W, DEEPNORM_BETA)
    mlstm_b_o = small(ks[11], (n_ml, D_MODEL))
    mod_w = w(ks[12], (DEPTH, D_MODEL, 6 * D_MODEL), D_MODEL, 0.5)
    mod_b = small(ks[13], (DEPTH, 6 * D_MODEL))
    mlp_w1 = w(ks[14], (DEPTH, D_MODEL, D_FF), D_MODEL)
    mlp_b1 = small(ks[15], (DEPTH, D_FF))
    mlp_w2 = w(ks[16], (DEPTH, D_FF, D_MODEL), D_FF, DEEPNORM_BETA)
    mlp_b2 = small(ks[17], (DEPTH, D_MODEL))
    ln_mix_g = 1.0 + small(ks[18], (DEPTH, D_MODEL))
    ln_mix_b = small(ks[19], (DEPTH, D_MODEL))
    ln_mlp_g = 1.0 + small(ks[20], (DEPTH, D_MODEL))
    ln_mlp_b = small(ks[21], (DEPTH, D_MODEL))
    return {'x': x, 'c': c, 'positions': positions,
            'attn_w_qkv': attn_w_qkv, 'attn_b_qkv': attn_b_qkv, 'attn_sink': attn_sink,
            'attn_w_o': attn_w_o, 'attn_b_o': attn_b_o,
            'mlstm_w_in': mlstm_w_in, 'mlstm_b_in': mlstm_b_in, 'mlstm_norm_w': mlstm_norm_w,
            'mlstm_w_o': mlstm_w_o, 'mlstm_b_o': mlstm_b_o,
            'mod_w': mod_w, 'mod_b': mod_b,
            'mlp_w1': mlp_w1, 'mlp_b1': mlp_b1, 'mlp_w2': mlp_w2, 'mlp_b2': mlp_b2,
            'ln_mix_g': ln_mix_g, 'ln_mix_b': ln_mix_b, 'ln_mlp_g': ln_mlp_g, 'ln_mlp_b': ln_mlp_b}


def reference(x, c, positions, attn_w_qkv, attn_b_qkv, attn_sink, attn_w_o, attn_b_o,
              mlstm_w_in, mlstm_b_in, mlstm_norm_w, mlstm_w_o, mlstm_b_o,
              mod_w, mod_b, mlp_w1, mlp_b1, mlp_w2, mlp_b2,
              ln_mix_g, ln_mix_b, ln_mlp_g, ln_mlp_b):
    c_act = jax.nn.silu(c)
    for i in range(DEPTH):
        mod = c_act @ mod_w[i] + mod_b[i]
        sh_m, sc_m, g_m, sh_f, sc_f, g_f = jnp.split(mod, 6, axis=-1)
        hmix = x * (1.0 + sc_m[:, None, :]) + sh_m[:, None, :]
        j = i // N_MIXERS
        if i % N_MIXERS == 0:
            y = windowed_gqa_sink(hmix, positions, attn_w_qkv[j], attn_b_qkv[j], attn_sink[j],
                                  attn_w_o[j], attn_b_o[j])
        else:
            y = bidir_mlstm(hmix, mlstm_w_in[j], mlstm_b_in[j], mlstm_norm_w[j],
                            mlstm_w_o[j], mlstm_b_o[j])
        x = layer_norm(DEEPNORM_ALPHA * x + (1.0 + g_m[:, None, :]) * y, ln_mix_g[i], ln_mix_b[i])
        hff = x * (1.0 + sc_f[:, None, :]) + sh_f[:, None, :]
        y = sq_relu_mlp(hff, mlp_w1[i], mlp_b1[i], mlp_w2[i], mlp_b2[i])
        x = layer_norm(DEEPNORM_ALPHA * x + (1.0 + g_f[:, None, :]) * y, ln_mlp_g[i], ln_mlp_b[i])
    return x
```

```cpp
#include <hip/hip_runtime.h>
#include <cstdio>
#include <cstdint>
#include <cmath>

namespace {
constexpr int D = 2048, BATCH = 4, SEQ = 2048, M = BATCH * SEQ;
constexpr int QKV_W = 3072, HD = 64, NQH = 32, NKVH = 8;
constexpr int ML_H = 4, ML_DV = 512, ML_DK = 256, ML_IN = 6160;
constexpr int DFF = 8192;
constexpr float ALPHA = 1.4142135623730951f;
constexpr float LN_EPS = 1e-5f, HN_EPS = 1e-6f;

__global__ void __launch_bounds__(512) mod_kernel(const float* __restrict__ c, const float* __restrict__ mod_w, const float* __restrict__ mod_b, float* __restrict__ mod) {
    __shared__ float sc[BATCH][D];
    __shared__ float red[8][BATCH][64];
    const int l = blockIdx.y, j = blockIdx.x * 64 + (threadIdx.x & 63), ks = threadIdx.x >> 6;
    for (int i = threadIdx.x; i < BATCH * D; i += 512) { const float v = c[i]; sc[i / D][i % D] = v / (1.f + expf(-v)); }
    __syncthreads();
    const float* w = mod_w + (size_t)l * D * (6 * D) + j;
    float a0 = 0.f, a1 = 0.f, a2 = 0.f, a3 = 0.f;
    for (int k = ks * 256; k < ks * 256 + 256; ++k) { const float wv = w[(size_t)k * (6 * D)]; a0 += sc[0][k] * wv; a1 += sc[1][k] * wv; a2 += sc[2][k] * wv; a3 += sc[3][k] * wv; }
    red[ks][0][threadIdx.x & 63] = a0; red[ks][1][threadIdx.x & 63] = a1; red[ks][2][threadIdx.x & 63] = a2; red[ks][3][threadIdx.x & 63] = a3;
    __syncthreads();
    if (threadIdx.x < 256) { const int b = threadIdx.x >> 6, jj = threadIdx.x & 63; float s = 0.f;
        for (int q = 0; q < 8; ++q) s += red[q][b][jj];
        mod[((size_t)l * BATCH + b) * (6 * D) + blockIdx.x * 64 + jj] = s + mod_b[(size_t)l * 6 * D + blockIdx.x * 64 + jj]; }
}

__global__ void modulate_kernel(const float* __restrict__ x, const float* __restrict__ modl, int sh_off, int sc_off, float* __restrict__ h) {
    const size_t i = (size_t)blockIdx.x * blockDim.x + threadIdx.x; if (i >= (size_t)M * D) return;
    const int col = (int)(i % D), b = (int)(i / ((size_t)SEQ * D));
    const float* mr = modl + (size_t)b * 6 * D;
    h[i] = x[i] * (1.f + mr[sc_off + col]) + mr[sh_off + col];
}

template <int EPI> __global__ void __launch_bounds__(256) gemm_f32(const float* __restrict__ A, const float* __restrict__ W, const float* __restrict__ bias, float* __restrict__ C,
                                                                   int Mr, int N, int K, const float* __restrict__ res, const float* __restrict__ gate) {
    __shared__ float As[16][68];
    __shared__ float Ws[16][68];
    const int tx = threadIdx.x & 15, ty = threadIdx.x >> 4, row0 = blockIdx.y * 64, col0 = blockIdx.x * 64;
    float acc[4][4];
#pragma unroll
    for (int i = 0; i < 4; ++i)
#pragma unroll
        for (int j = 0; j < 4; ++j) acc[i][j] = 0.f;
    for (int k0 = 0; k0 < K; k0 += 16) {
        { const int r = threadIdx.x >> 2, kq = (threadIdx.x & 3) * 4; const float4 v = *(const float4*)(A + (size_t)(row0 + r) * K + k0 + kq);
          As[kq + 0][r] = v.x; As[kq + 1][r] = v.y; As[kq + 2][r] = v.z; As[kq + 3][r] = v.w; }
        { const int kk = threadIdx.x >> 4, cq = (threadIdx.x & 15) * 4; float4 v = make_float4(0.f, 0.f, 0.f, 0.f);
          if (col0 + cq < N) v = *(const float4*)(W + (size_t)(k0 + kk) * N + col0 + cq);
          Ws[kk][cq + 0] = v.x; Ws[kk][cq + 1] = v.y; Ws[kk][cq + 2] = v.z; Ws[kk][cq + 3] = v.w; }
        __syncthreads();
#pragma unroll
        for (int kk = 0; kk < 16; ++kk) {
            float a[4], b[4];
#pragma unroll
            for (int i = 0; i < 4; ++i) a[i] = As[kk][ty * 4 + i];
#pragma unroll
            for (int j = 0; j < 4; ++j) b[j] = Ws[kk][tx * 4 + j];
#pragma unroll
            for (int i = 0; i < 4; ++i)
#pragma unroll
                for (int j = 0; j < 4; ++j) acc[i][j] += a[i] * b[j];
        }
        __syncthreads();
    }
#pragma unroll
    for (int i = 0; i < 4; ++i) {
        const int row = row0 + ty * 4 + i;
#pragma unroll
        for (int j = 0; j < 4; ++j) {
            const int col = col0 + tx * 4 + j; if (col >= N) continue;
            float v = acc[i][j] + bias[col];
            if (EPI == 1) { v = v > 0.f ? v : 0.f; v = v * v; }
            if (EPI == 2) { const int b = row / SEQ; v = ALPHA * res[(size_t)row * N + col] + (1.f + gate[(size_t)b * 6 * D + col]) * v; }
            C[(size_t)row * N + col] = v;
        }
    }
}

__global__ void rope_kernel(float* __restrict__ qkv, const int* __restrict__ positions) {
    const size_t i = (size_t)blockIdx.x * blockDim.x + threadIdx.x;
    if (i >= (size_t)M * 40 * 32) return;
    const int p = (int)(i & 31), hh = (int)((i >> 5) % 40), row = (int)(i / (40 * 32));
    const float inv_freq = 1.0f / powf(10000.0f, (float)(2 * p) / 64.0f);
    const float ang = (float)positions[row] * inv_freq;
    const float cs = cosf(ang), sn = sinf(ang);
    float* base = qkv + (size_t)row * QKV_W + hh * 64;
    const float t1 = base[p], t2 = base[p + 32];
    base[p] = t1 * cs - t2 * sn; base[p + 32] = t2 * cs + t1 * sn;
}

__global__ void __launch_bounds__(64) attn_kernel(const float* __restrict__ qkv, const float* __restrict__ sink, float* __restrict__ o) {
    const int b = blockIdx.z, h = blockIdx.y, q0 = blockIdx.x * 64, qi = q0 + threadIdx.x, kvh = h / 4;
    const float* qrow = qkv + ((size_t)b * SEQ + qi) * QKV_W + h * 64;
    float q[64], acc[64];
#pragma unroll
    for (int d = 0; d < 64; ++d) { q[d] = qrow[d] * 0.125f; acc[d] = 0.f; }
    float m = sink[h], l = 1.f;
    int klo = q0 - 128; if (klo < 0) klo = 0; int khi = q0 + 63 + 128; if (khi > SEQ - 1) khi = SEQ - 1;
    for (int kp = klo; kp <= khi; ++kp) {
        const float* krow = qkv + ((size_t)b * SEQ + kp) * QKV_W + 2048 + kvh * 64;
        const float* vrow = krow + 512;
        float s = 0.f;
#pragma unroll
        for (int d = 0; d < 64; ++d) s += q[d] * krow[d];
        int dd = kp - qi; if (dd < 0) dd = -dd;
        const int blk = (qi / 128) * 128;
        const bool valid = dd <= 128 && kp >= blk - 128 && kp < blk + 256;
        if (valid) {
            const float mn = fmaxf(m, s), f = expf(m - mn), p = expf(s - mn);
            l = l * f + p;
#pragma unroll
            for (int d = 0; d < 64; ++d) acc[d] = acc[d] * f + p * vrow[d];
            m = mn;
        }
    }
    float* orow = o + ((size_t)b * SEQ + qi) * D + h * 64;
    const float il = 1.f / l;
#pragma unroll
    for (int d = 0; d < 64; ++d) orow[d] = acc[d] * il;
}

__global__ void __launch_bounds__(256) ln_mod_kernel(const float* __restrict__ z, const float* __restrict__ g, const float* __restrict__ bta, float* __restrict__ xo,
                                                     const float* __restrict__ modl, int sh_off, int sc_off, float* __restrict__ h) {
    __shared__ float red[8];
    const int row = blockIdx.x, b = row / SEQ, t = threadIdx.x;
    const float* zr = z + (size_t)row * D;
    float v[8]; float s = 0.f;
#pragma unroll
    for (int i = 0; i < 8; ++i) { v[i] = zr[t + 256 * i]; s += v[i]; }
    for (int o = 32; o > 0; o >>= 1) s += __shfl_xor(s, o);
    if ((t & 63) == 0) red[t >> 6] = s;
    __syncthreads();
    const float mean = (red[0] + red[1] + red[2] + red[3]) * (1.f / D);
    float s2 = 0.f;
#pragma unroll
    for (int i = 0; i < 8; ++i) { v[i] -= mean; s2 += v[i] * v[i]; }
    for (int o = 32; o > 0; o >>= 1) s2 += __shfl_xor(s2, o);
    if ((t & 63) == 0) red[4 + (t >> 6)] = s2;
    __syncthreads();
    const float rstd = rsqrtf((red[4] + red[5] + red[6] + red[7]) * (1.f / D) + LN_EPS);
#pragma unroll
    for (int i = 0; i < 8; ++i) { const int col = t + 256 * i; const float y = v[i] * rstd * g[col] + bta[col];
        xo[(size_t)row * D + col] = y;
        if (h) { const float* mr = modl + (size_t)b * 6 * D; h[(size_t)row * D + col] = y * (1.f + mr[sc_off + col]) + mr[sh_off + col]; } }
}

__global__ void __launch_bounds__(256) mlstm_rec_kernel(const float* __restrict__ proj, float* __restrict__ hz) {
    __shared__ float qs[256], ks[256], vs[64], part[2][4][64];
    const int sl = blockIdx.x, h = blockIdx.y, z = blockIdx.z, dir = z / BATCH, b = z % BATCH;
    const int tid = threadIdx.x, dv = tid & 63, dkq = tid >> 6;
    float C[64], n[64];
#pragma unroll
    for (int j = 0; j < 64; ++j) { C[j] = 0.f; n[j] = 0.f; }
    float m = -1e30f;
    float* out = hz + (size_t)dir * M * D;
    for (int step = 0; step < SEQ; ++step) {
        const int t = dir ? (SEQ - 1 - step) : step;
        const float* pr = proj + ((size_t)b * SEQ + t) * ML_IN;
        qs[tid] = pr[h * ML_DK + tid] * 0.0625f; ks[tid] = pr[1024 + h * ML_DK + tid];
        if (tid < 64) vs[tid] = pr[2048 + h * ML_DV + sl * 64 + tid];
        const float li = pr[6144 + (dir ? 8 : 0) + h], fp = pr[6144 + (dir ? 12 : 4) + h];
        const float lf = fminf(fp, 0.f) - log1pf(expf(-fabsf(fp)));
        const float mn = fmaxf(lf + m, li), fd = expf(lf + m - mn), fi = expf(li - mn);
        m = mn;
        __syncthreads();
        const float kv = fi * vs[dv];
        float pn = 0.f, pd = 0.f;
#pragma unroll
        for (int j = 0; j < 64; ++j) { const float kk = ks[dkq * 64 + j], qq = qs[dkq * 64 + j];
            C[j] = fd * C[j] + kk * kv; n[j] = fd * n[j] + fi * kk; pn += qq * C[j]; pd += qq * n[j]; }
        part[0][dkq][dv] = pn; part[1][dkq][dv] = pd;
        __syncthreads();
        if (tid < 64) { const float num = part[0][0][tid] + part[0][1][tid] + part[0][2][tid] + part[0][3][tid];
            const float den = part[1][0][tid] + part[1][1][tid] + part[1][2][tid] + part[1][3][tid];
            out[((size_t)b * SEQ + t) * D + h * ML_DV + sl * 64 + tid] = num / fmaxf(fabsf(den), expf(-mn)); }
        __syncthreads();
    }
}

__global__ void __launch_bounds__(256) headnorm_kernel(const float* __restrict__ hz, const float* __restrict__ proj, const float* __restrict__ norm_w, float* __restrict__ y) {
    __shared__ float red[8];
    const int h = blockIdx.x, row = blockIdx.y, t = threadIdx.x;
    const size_t base = (size_t)row * D + h * ML_DV;
    float v0 = hz[base + t] + hz[(size_t)M * D + base + t], v1 = hz[base + 256 + t] + hz[(size_t)M * D + base + 256 + t];
    float s = v0 + v1;
    for (int o = 32; o > 0; o >>= 1) s += __shfl_xor(s, o);
    if ((t & 63) == 0) red[t >> 6] = s;
    __syncthreads();
    const float mean = (red[0] + red[1] + red[2] + red[3]) * (1.f / ML_DV);
    v0 -= mean; v1 -= mean;
    float s2 = v0 * v0 + v1 * v1;
    for (int o = 32; o > 0; o >>= 1) s2 += __shfl_xor(s2, o);
    if ((t & 63) == 0) red[4 + (t >> 6)] = s2;
    __syncthreads();
    const float rstd = rsqrtf((red[4] + red[5] + red[6] + red[7]) * (1.f / ML_DV) + HN_EPS);
    const float* orow = proj + (size_t)row * ML_IN + 4096 + h * ML_DV;
    const float o0 = orow[t], o1 = orow[256 + t];
    y[base + t] = (1.f / (1.f + expf(-o0))) * (v0 * rstd * norm_w[h * ML_DV + t]);
    y[base + 256 + t] = (1.f / (1.f + expf(-o1))) * (v1 * rstd * norm_w[h * ML_DV + 256 + t]);
}
}

extern "C" void kernel_launch(void* const* d_in, const int* in_sizes, int n_in, void* d_out, int out_size, void* d_ws, size_t ws_size, hipStream_t stream) {
    const float* x = (const float*)d_in[0]; const float* c = (const float*)d_in[1]; const int* positions = (const int*)d_in[2];
    const float* attn_w_qkv = (const float*)d_in[3]; const float* attn_b_qkv = (const float*)d_in[4]; const float* attn_sink = (const float*)d_in[5];
    const float* attn_w_o = (const float*)d_in[6]; const float* attn_b_o = (const float*)d_in[7];
    const float* mlstm_w_in = (const float*)d_in[8]; const float* mlstm_b_in = (const float*)d_in[9]; const float* mlstm_norm_w = (const float*)d_in[10];
    const float* mlstm_w_o = (const float*)d_in[11]; const float* mlstm_b_o = (const float*)d_in[12];
    const float* mod_w = (const float*)d_in[13]; const float* mod_b = (const float*)d_in[14];
    const float* mlp_w1 = (const float*)d_in[15]; const float* mlp_b1 = (const float*)d_in[16]; const float* mlp_w2 = (const float*)d_in[17]; const float* mlp_b2 = (const float*)d_in[18];
    const float* ln_mix_g = (const float*)d_in[19]; const float* ln_mix_b = (const float*)d_in[20]; const float* ln_mlp_g = (const float*)d_in[21]; const float* ln_mlp_b = (const float*)d_in[22];
    float* out = (float*)d_out;
    const size_t MD = (size_t)M * D;
    char* ws = (char*)d_ws; size_t off = 0;
    auto carve = [&](size_t bytes) { char* p = ws + off; off += (bytes + 255) & ~(size_t)255; return p; };
    float* mod = (float*)carve((size_t)2 * BATCH * 6 * D * 4);
    float* h = (float*)carve(MD * 4);
    float* big = (float*)carve((size_t)M * DFF * 4);
    float* ao = (float*)carve(MD * 4);
    float* zb = (float*)carve(MD * 4);
    float* x1 = (float*)carve(MD * 4);
    float* x2 = (float*)carve(MD * 4);
    float* hz = (float*)carve(2 * MD * 4);
    if (off > ws_size) { fprintf(stderr, "kernel_launch: workspace too small: need %zu have %zu\n", off, ws_size); return; }

    mod_kernel<<<dim3(6 * D / 64, 2), 512, 0, stream>>>(c, mod_w, mod_b, mod);
    const int EW = (int)((MD + 255) / 256);
    const float* mod0 = mod; const float* mod1 = mod + (size_t)BATCH * 6 * D;
    modulate_kernel<<<EW, 256, 0, stream>>>(x, mod0, 0, D, h);
    gemm_f32<0><<<dim3(QKV_W / 64, M / 64), 256, 0, stream>>>(h, attn_w_qkv, attn_b_qkv, big, M, QKV_W, D, nullptr, nullptr);
    rope_kernel<<<(M * 40 * 32 + 255) / 256, 256, 0, stream>>>(big, positions);
    attn_kernel<<<dim3(SEQ / 64, NQH, BATCH), 64, 0, stream>>>(big, attn_sink, ao);
    gemm_f32<2><<<dim3(D / 64, M / 64), 256, 0, stream>>>(ao, attn_w_o, attn_b_o, zb, M, D, D, x, mod0 + 2 * D);
    ln_mod_kernel<<<M, 256, 0, stream>>>(zb, ln_mix_g, ln_mix_b, x1, mod0, 3 * D, 4 * D, h);
    gemm_f32<1><<<dim3(DFF / 64, M / 64), 256, 0, stream>>>(h, mlp_w1, mlp_b1, big, M, DFF, D, nullptr, nullptr);
    gemm_f32<2><<<dim3(D / 64, M / 64), 256, 0, stream>>>(big, mlp_w2, mlp_b2, zb, M, D, DFF, x1, mod0 + 5 * D);
    ln_mod_kernel<<<M, 256, 0, stream>>>(zb, ln_mlp_g, ln_mlp_b, x2, mod1, 0, D, h);
    gemm_f32<0><<<dim3((ML_IN + 63) / 64, M / 64), 256, 0, stream>>>(h, mlstm_w_in, mlstm_b_in, big, M, ML_IN, D, nullptr, nullptr);
    mlstm_rec_kernel<<<dim3(8, ML_H, 2 * BATCH), 256, 0, stream>>>(big, hz);
    headnorm_kernel<<<dim3(ML_H, M), 256, 0, stream>>>(hz, big, mlstm_norm_w, ao);
    gemm_f32<2><<<dim3(D / 64, M / 64), 256, 0, stream>>>(ao, mlstm_w_o, mlstm_b_o, zb, M, D, D, x2, mod1 + 2 * D);
    ln_mod_kernel<<<M, 256, 0, stream>>>(zb, ln_mix_g + D, ln_mix_b + D, x1, mod1, 3 * D, 4 * D, h);
    gemm_f32<1><<<dim3(DFF / 64, M / 64), 256, 0, stream>>>(h, mlp_w1 + (size_t)D * DFF, mlp_b1 + DFF, big, M, DFF, D, nullptr, nullptr);
    gemm_f32<2><<<dim3(D / 64, M / 64), 256, 0, stream>>>(big, mlp_w2 + (size_t)DFF * D, mlp_b2 + D, zb, M, D, DFF, x1, mod1 + 5 * D);
    ln_mod_kernel<<<M, 256, 0, stream>>>(zb, ln_mlp_g + D, ln_mlp_b + D, out, nullptr, 0, 0, nullptr);
}
```

```cpp
#include <hip/hip_runtime.h>
#include <hip/hip_cooperative_groups.h>
#include <cstdio>
#include <cstdint>
#include <cmath>

constexpr int D = 2048, BATCH = 4, SEQ = 2048, M = BATCH * SEQ;
constexpr int QKV_W = 3072, NQH = 32, NKVH = 8;
constexpr int ML_H = 4, ML_DV = 512, ML_DK = 256, ML_IN = 6160, ML_INP = 6144;
constexpr int DFF = 8192;
constexpr float ALPHA = 1.4142135623730951f;
constexpr float LN_EPS = 1e-5f, HN_EPS = 1e-6f;
constexpr float LOG2E = 1.4426950408889634f;
constexpr float QSCALE = 0.125f * LOG2E;
constexpr int NWAVES = 8, NTHREADS = 512;

namespace pg8 {
#define PG8_LAS __attribute__((address_space(3)))
typedef unsigned short bf16_t;
typedef short bf16x8 __attribute__((ext_vector_type(8)));
typedef float f32x4 __attribute__((ext_vector_type(4)));
typedef unsigned u32x4 __attribute__((ext_vector_type(4)));
constexpr int BM = 256, BK = 64, HALF = 128, HTB = HALF * BK * 2  , STAGE_BYTES = 8 * HTB, NXCD = 8, WGM = 8;

__host__ __device__ __forceinline__ int lds_byte(int r, int c) { const int st = (r >> 4) * 2 + (c >> 5), rr = r & 15, cc = c & 31, ob = rr * 64 + cc * 2; return st * 1024 + (ob ^ (((ob >> 9) & 1) << 5)); }
__host__ __device__ __forceinline__ void stage_rc(int b, int& R, int& C) { const int st = b / 1024, sb = b % 1024, swz = sb ^ (((sb >> 9) & 1) << 5); R = (st >> 1) * 16 + swz / 64; C = (st & 1) * 32 + (swz % 64) / 2; }
__host__ __device__ __forceinline__ int perm32(int rho) { const int n = rho >> 4, i = rho & 15; return 8 * (i >> 2) + 4 * n + (i & 3); }

struct Unit { int pm, pn; };
struct Gemm { const bf16_t* A; const bf16_t* Bt; int M, N, K; };

struct StaticOrder {
    int nM, nN, nwg, G, c;
    __host__ __device__ void init(int M, int N, int G_, int c_) { nM = M / BM; nN = N / BM; nwg = nM * nN; G = G_; c = c_; }
    __host__ __device__ bool next(int i, Unit& u) const {
        const long L = (long)i * G + c; if (L >= nwg) return false;
        int wgid = (int)L; { const int q = nwg / NXCD, r = nwg % NXCD, xcd = wgid % NXCD, off = wgid / NXCD; wgid = (xcd < r ? xcd * (q + 1) : r * (q + 1) + (xcd - r) * q) + off; }
        const int nig = WGM * nN, gid = wgid / nig, fm = gid * WGM, gsz = (nM - fm) < WGM ? (nM - fm) : WGM;
        u.pm = fm + ((wgid % nig) % gsz); u.pn = (wgid % nig) / gsz; return true;
    }
    __device__ __forceinline__ void a_ready(const Unit&) const {}
    __device__ __forceinline__ void done(const Unit&) const {}
};

__device__ __forceinline__ unsigned cvt_pk_bf16(float lo, float hi) { unsigned r; asm volatile("v_cvt_pk_bf16_f32 %0, %1, %2" : "=v"(r) : "v"(lo), "v"(hi)); return r; }

template <int ACT> struct EpiBf16 {
    static constexpr int PERM = 1; static constexpr bool AFTER_DRAIN = false;
    bf16_t* O; int ldc; const float* bias; int npn0; float scale0;
    __device__ __forceinline__ void operator()(const f32x4 (&acc)[2][2][4][2], const Unit& u, int wr, int wc, int fr, int fq) const {
        const int row0 = u.pm * BM + wr * 64 + fr, col0 = u.pn * BM + wc * 32 + 8 * fq;
        const float sc = (u.pn < npn0) ? scale0 : 1.f;
        f32x4 bv[2][2];
#pragma unroll
        for (int bj = 0; bj < 2; ++bj)
#pragma unroll
            for (int n = 0; n < 2; ++n) bv[bj][n] = *(const f32x4*)(bias + col0 + bj * HALF + 4 * n);
#pragma unroll
        for (int ai = 0; ai < 2; ++ai)
#pragma unroll
            for (int m = 0; m < 4; ++m) { bf16_t* rowp = O + (size_t)(row0 + ai * HALF + m * 16) * ldc + col0;
#pragma unroll
                for (int bj = 0; bj < 2; ++bj) { f32x4 v0 = acc[ai][bj][m][0] + bv[bj][0], v1 = acc[ai][bj][m][1] + bv[bj][1];
                    if (ACT == 1) {
#pragma unroll
                        for (int e = 0; e < 4; ++e) { float a = v0[e] > 0.f ? v0[e] : 0.f, b = v1[e] > 0.f ? v1[e] : 0.f; v0[e] = a * a; v1[e] = b * b; } }
                    v0 = v0 * sc; v1 = v1 * sc; u32x4 w; w.x = cvt_pk_bf16(v0[0], v0[1]); w.y = cvt_pk_bf16(v0[2], v0[3]); w.z = cvt_pk_bf16(v1[0], v1[1]); w.w = cvt_pk_bf16(v1[2], v1[3]);
                    *(u32x4*)(rowp + bj * HALF) = w; } }
    }
};

struct EpiQKV {
    static constexpr int PERM = 2; static constexpr bool AFTER_DRAIN = false;
    bf16_t* O; int ldc; const float* bias; const float* cosT; const float* sinT; int npn_q, npn_rope; float qscale;
    __device__ __forceinline__ void operator()(const f32x4 (&acc)[2][2][4][2], const Unit& u, int wr, int wc, int fr, int fq) const {
        const int row0 = u.pm * BM + wr * 64 + fr, col0 = u.pn * BM + wc * 64 + 8 * fq;
        const float sc = (u.pn < npn_q) ? qscale : 1.f; const bool rope = u.pn < npn_rope;
        f32x4 bv[2][2];
#pragma unroll
        for (int bj = 0; bj < 2; ++bj)
#pragma unroll
            for (int n = 0; n < 2; ++n) bv[bj][n] = *(const f32x4*)(bias + col0 + bj * 32 + 4 * n);
#pragma unroll
        for (int ai = 0; ai < 2; ++ai)
#pragma unroll
            for (int m = 0; m < 4; ++m) { const int row = row0 + ai * HALF + m * 16; bf16_t* rowp = O + (size_t)row * ldc + col0;
                f32x4 lo0 = acc[ai][0][m][0] + bv[0][0], lo1 = acc[ai][0][m][1] + bv[0][1], hi0 = acc[ai][1][m][0] + bv[1][0], hi1 = acc[ai][1][m][1] + bv[1][1];
                if (rope) { const f32x4 c0 = *(const f32x4*)(cosT + (size_t)row * 32 + 8 * fq), c1 = *(const f32x4*)(cosT + (size_t)row * 32 + 8 * fq + 4);
                    const f32x4 s0 = *(const f32x4*)(sinT + (size_t)row * 32 + 8 * fq), s1 = *(const f32x4*)(sinT + (size_t)row * 32 + 8 * fq + 4);
                    const f32x4 a0 = lo0 * c0 - hi0 * s0, a1 = lo1 * c1 - hi1 * s1, b0 = hi0 * c0 + lo0 * s0, b1 = hi1 * c1 + lo1 * s1;
                    lo0 = a0; lo1 = a1; hi0 = b0; hi1 = b1; }
                lo0 = lo0 * sc; lo1 = lo1 * sc; hi0 = hi0 * sc; hi1 = hi1 * sc;
                u32x4 w; w.x = cvt_pk_bf16(lo0[0], lo0[1]); w.y = cvt_pk_bf16(lo0[2], lo0[3]); w.z = cvt_pk_bf16(lo1[0], lo1[1]); w.w = cvt_pk_bf16(lo1[2], lo1[3]);
                *(u32x4*)(rowp) = w;
                w.x = cvt_pk_bf16(hi0[0], hi0[1]); w.y = cvt_pk_bf16(hi0[2], hi0[3]); w.z = cvt_pk_bf16(hi1[0], hi1[1]); w.w = cvt_pk_bf16(hi1[2], hi1[3]);
                *(u32x4*)(rowp + 32) = w; }
    }
};

struct EpiRes {
    static constexpr int PERM = 1; static constexpr bool AFTER_DRAIN = false;
    float* Z; int ldc; const float* bias; const float* res; const float* gate; int gate_ld; int tiles_per_batch; float alpha;
    __device__ __forceinline__ void operator()(const f32x4 (&acc)[2][2][4][2], const Unit& u, int wr, int wc, int fr, int fq) const {
        const int row0 = u.pm * BM + wr * 64 + fr, col0 = u.pn * BM + wc * 32 + 8 * fq;
        const float* gp = gate + (size_t)(u.pm / tiles_per_batch) * gate_ld;
        f32x4 bv[2][2], gv[2][2];
#pragma unroll
        for (int bj = 0; bj < 2; ++bj)
#pragma unroll
            for (int n = 0; n < 2; ++n) { bv[bj][n] = *(const f32x4*)(bias + col0 + bj * HALF + 4 * n); gv[bj][n] = *(const f32x4*)(gp + col0 + bj * HALF + 4 * n) + 1.0f; }
#pragma unroll
        for (int ai = 0; ai < 2; ++ai)
#pragma unroll
            for (int m = 0; m < 4; ++m) { const size_t off = (size_t)(row0 + ai * HALF + m * 16) * ldc + col0;
#pragma unroll
                for (int bj = 0; bj < 2; ++bj)
#pragma unroll
                    for (int n = 0; n < 2; ++n) { const f32x4 r = *(const f32x4*)(res + off + bj * HALF + 4 * n);
                        *(f32x4*)(Z + off + bj * HALF + 4 * n) = r * alpha + gv[bj][n] * (acc[ai][bj][m][n] + bv[bj][n]); }
                asm volatile("" ::: "memory"); }
    }
};

template <class Epi, class Sched, bool ALIGN_EPI = false, bool SP2 = false>
__device__ __forceinline__ void gemm_phase(PG8_LAS unsigned char* lds, const Gemm g, const Sched& S, const Epi& E) {
    const int tid = threadIdx.x, wid = __builtin_amdgcn_readfirstlane(tid >> 6), lane = tid & 63, wr = wid >> 2, wc = wid & 3, fr = lane & 15, fq = lane >> 4;
    const int K = g.K, nt = K / BK;
    unsigned voffA[2], voffB[2];
#pragma unroll
    for (int i = 0; i < 2; ++i) { int R, C; stage_rc(tid * 16 + i * 8192, R, C); const int Rb = (Epi::PERM == 2) ? (64 * (R >> 5) + perm32(R & 31)) : (Epi::PERM == 1) ? ((R & ~31) + perm32(R & 31)) : R;
        voffA[i] = (unsigned)(R * K + C) * 2u; voffB[i] = (unsigned)(Rb * K + C) * 2u; }
    const size_t kstep = (size_t)(BK * 2);
    const size_t hstep = (size_t)HALF * K * 2;
    const size_t tstep = 2 * hstep;
    const size_t bhstep = (Epi::PERM == 2) ? (size_t)32 * K * 2 : hstep;
    const unsigned ldsw = (unsigned)wid * 1024u;
    const int aoff = lds_byte(wr * 64 + fr, fq * 8), boff = lds_byte(wc * 32 + fr, fq * 8);
#define PG8_SA(b, h) (((b) * 2 + (h)) * HTB)
#define PG8_SB(b, h) ((4 + (b) * 2 + (h)) * HTB)
#define PG8_STAGE(bufoff, gbase, voff) do { _Pragma("unroll") for (int _i = 0; _i < 2; ++_i) \
        __builtin_amdgcn_global_load_lds((const unsigned*)((const char*)(gbase) + (voff)[_i]), (PG8_LAS unsigned*)(lds + (bufoff) + ldsw + _i * 8192), 16, 0, 0); } while (0)
#define PG8_LDA(dst, b, h) do { _Pragma("unroll") for (int m = 0; m < 4; ++m) _Pragma("unroll") for (int k = 0; k < 2; ++k) dst[m][k] = *(const PG8_LAS bf16x8*)(lds + PG8_SA(b, h) + aoff + m * 2048 + k * 1024); } while (0)
#define PG8_LDB(dst, b, h) do { _Pragma("unroll") for (int n = 0; n < 2; ++n) _Pragma("unroll") for (int k = 0; k < 2; ++k) dst[n][k] = *(const PG8_LAS bf16x8*)(lds + PG8_SB(b, h) + boff + n * 2048 + k * 1024); } while (0)
#define PG8_MMA(ai, bj, At, Bt) do { __builtin_amdgcn_s_setprio(1); _Pragma("unroll") for (int m = 0; m < 4; ++m) _Pragma("unroll") for (int n = 0; n < 2; ++n) _Pragma("unroll") for (int k = 0; k < 2; ++k) \
        acc[ai][bj][m][n] = __builtin_amdgcn_mfma_f32_16x16x32_bf16(Bt[n][k], At[m][k], acc[ai][bj][m][n], 0, 0, 0); __builtin_amdgcn_s_setprio(0); } while (0)
#define PG8_WAIT_V(n) asm volatile("s_waitcnt vmcnt(" #n ")" ::: "memory")
#define PG8_WAIT_L(n) asm volatile("s_waitcnt lgkmcnt(" #n ")" ::: "memory")
#define PG8_BAR __builtin_amdgcn_s_barrier()
#define PG8_SCHED __builtin_amdgcn_sched_barrier(0)
    Unit cur, nxt; int ui = 0;
    if (!S.next(0, cur)) return;
    f32x4 acc[2][2][4][2];
#pragma unroll
    for (int a = 0; a < 2; ++a)
#pragma unroll
        for (int b = 0; b < 2; ++b)
#pragma unroll
            for (int m = 0; m < 4; ++m)
#pragma unroll
                for (int n = 0; n < 2; ++n) acc[a][b][m][n] = (f32x4){0.f, 0.f, 0.f, 0.f};
    bf16x8 At[4][2], B0[2][2], B1[2][2];
    const char* cA = (const char*)g.A + (size_t)cur.pm * tstep; const char* cB = (const char*)g.Bt + (size_t)cur.pn * tstep;
    S.a_ready(cur);
    if constexpr (SP2) {
        PG8_STAGE(PG8_SB(0, 0), cB, voffB); PG8_STAGE(PG8_SB(0, 1), cB + bhstep, voffB); PG8_STAGE(PG8_SA(0, 0), cA, voffA); PG8_STAGE(PG8_SA(0, 1), cA + hstep, voffA);
        if (wr == 1) PG8_BAR;
        PG8_WAIT_V(2); PG8_BAR;
        PG8_STAGE(PG8_SB(1, 0), cB + kstep, voffB); PG8_STAGE(PG8_SA(1, 0), cA + kstep, voffA); PG8_STAGE(PG8_SB(1, 1), cB + bhstep + kstep, voffB);
        PG8_WAIT_V(6); PG8_BAR;
    } else {
        PG8_STAGE(PG8_SB(0, 0), cB, voffB); PG8_STAGE(PG8_SA(0, 0), cA, voffA); PG8_STAGE(PG8_SB(0, 1), cB + bhstep, voffB); PG8_STAGE(PG8_SA(0, 1), cA + hstep, voffA);
        if (wr == 1) PG8_BAR;
        PG8_WAIT_V(4); PG8_BAR;
        PG8_STAGE(PG8_SB(1, 0), cB + kstep, voffB); PG8_STAGE(PG8_SA(1, 0), cA + kstep, voffA); PG8_STAGE(PG8_SB(1, 1), cB + bhstep + kstep, voffB);
        PG8_WAIT_V(6); PG8_BAR;
    }
    for (;;) {
        const bool has_next = S.next(ui + 1, nxt);
        const char* nA = has_next ? (const char*)g.A + (size_t)nxt.pm * tstep : cA; const char* nB = has_next ? (const char*)g.Bt + (size_t)nxt.pn * tstep : cB;
        for (int t = 0; t < nt; t += 2) {
            const bool last = (t == nt - 2);
            const char* a1 = cA + (size_t)(t + 1) * kstep;
            const char* a2 = last ? nA : cA + (size_t)(t + 2) * kstep; const char* b2 = last ? nB : cB + (size_t)(t + 2) * kstep;
            const char* a3 = a2 + kstep; const char* b3 = b2 + kstep;
            if (last && has_next) S.a_ready(nxt);
            if constexpr (SP2) {
            PG8_LDB(B0, 0, 0); PG8_LDB(B1, 0, 1); PG8_SCHED; PG8_LDA(At, 0, 0); PG8_STAGE(PG8_SA(1, 1), a1 + hstep, voffA);
            PG8_WAIT_V(8); PG8_WAIT_L(0); PG8_BAR; PG8_MMA(0, 0, At, B0); PG8_MMA(0, 1, At, B1); PG8_BAR; PG8_SCHED;
            PG8_LDA(At, 0, 1); PG8_STAGE(PG8_SB(0, 0), b2, voffB); PG8_STAGE(PG8_SB(0, 1), b2 + bhstep, voffB); PG8_STAGE(PG8_SA(0, 0), a2, voffA);
            PG8_WAIT_V(8); PG8_WAIT_L(0); PG8_BAR; PG8_MMA(1, 0, At, B0); PG8_MMA(1, 1, At, B1); PG8_BAR; PG8_SCHED;
            PG8_LDB(B0, 1, 0); PG8_LDB(B1, 1, 1); PG8_SCHED; PG8_LDA(At, 1, 0); PG8_STAGE(PG8_SA(0, 1), a2 + hstep, voffA);
            PG8_WAIT_V(8); PG8_WAIT_L(0); PG8_BAR; PG8_MMA(0, 0, At, B0); PG8_MMA(0, 1, At, B1); PG8_BAR; PG8_SCHED;
            PG8_LDA(At, 1, 1); PG8_STAGE(PG8_SB(1, 0), b3, voffB); PG8_STAGE(PG8_SB(1, 1), b3 + bhstep, voffB); PG8_STAGE(PG8_SA(1, 0), a3, voffA);
            PG8_WAIT_V(8); PG8_WAIT_L(0); PG8_BAR; PG8_MMA(1, 0, At, B0); PG8_MMA(1, 1, At, B1); PG8_BAR; PG8_SCHED;
            } else {
            PG8_LDB(B0, 0, 0); PG8_SCHED; PG8_LDA(At, 0, 0); PG8_STAGE(PG8_SA(1, 1), a1 + hstep, voffA);
            PG8_WAIT_L(8); PG8_BAR; PG8_WAIT_L(0); PG8_MMA(0, 0, At, B0); PG8_BAR; PG8_SCHED;
            PG8_LDB(B1, 0, 1); PG8_STAGE(PG8_SB(0, 0), b2, voffB);
            PG8_BAR; PG8_WAIT_L(0); PG8_MMA(0, 1, At, B1); PG8_BAR;
            PG8_LDA(At, 0, 1); PG8_STAGE(PG8_SA(0, 0), a2, voffA);
            PG8_BAR; PG8_WAIT_L(0); PG8_MMA(1, 0, At, B0); PG8_BAR; PG8_SCHED;
            PG8_STAGE(PG8_SB(0, 1), b2 + bhstep, voffB);
            PG8_WAIT_V(6); PG8_BAR; PG8_MMA(1, 1, At, B1); PG8_BAR;
            PG8_LDB(B0, 1, 0); PG8_SCHED; PG8_LDA(At, 1, 0); PG8_STAGE(PG8_SA(0, 1), a2 + hstep, voffA);
            PG8_WAIT_L(8); PG8_BAR; PG8_WAIT_L(0); PG8_MMA(0, 0, At, B0); PG8_BAR; PG8_SCHED;
            PG8_LDB(B1, 1, 1); PG8_STAGE(PG8_SB(1, 0), b3, voffB);
            PG8_BAR; PG8_WAIT_L(0); PG8_MMA(0, 1, At, B1); PG8_BAR;
            PG8_LDA(At, 1, 1); PG8_STAGE(PG8_SA(1, 0), a3, voffA);
            PG8_BAR; PG8_WAIT_L(0); PG8_MMA(1, 0, At, B0); PG8_BAR; PG8_SCHED;
            PG8_STAGE(PG8_SB(1, 1), b3 + bhstep, voffB);
            PG8_WAIT_V(6); PG8_BAR; PG8_MMA(1, 1, At, B1); PG8_BAR;
            }
        }
        if constexpr (ALIGN_EPI) { if (wr == 0) PG8_BAR; }
        if constexpr (!Epi::AFTER_DRAIN) { E(acc, cur, wr, wc, fr, fq); S.done(cur); }
        if (!has_next) break;
#pragma unroll
        for (int a = 0; a < 2; ++a)
#pragma unroll
            for (int b = 0; b < 2; ++b)
#pragma unroll
                for (int m = 0; m < 4; ++m)
#pragma unroll
                    for (int n = 0; n < 2; ++n) acc[a][b][m][n] = (f32x4){0.f, 0.f, 0.f, 0.f};
        cur = nxt; cA = nA; cB = nB; ++ui;
        if constexpr (ALIGN_EPI) { if (wr == 1) PG8_BAR; }
    }
    PG8_WAIT_V(0);
    if constexpr (!ALIGN_EPI) { if (wr == 0) PG8_BAR; }
    PG8_BAR;
    if constexpr (Epi::AFTER_DRAIN) { E.fused(acc, cur, wr, wc, fr, fq, lds, wid, lane); S.done(cur); }
#undef PG8_SA
#undef PG8_SB
#undef PG8_STAGE
#undef PG8_LDA
#undef PG8_LDB
#undef PG8_MMA
#undef PG8_WAIT_V
#undef PG8_WAIT_L
#undef PG8_BAR
#undef PG8_SCHED
}
}

#define LAS __attribute__((address_space(3)))
typedef unsigned short bf16;
typedef unsigned v4u __attribute__((ext_vector_type(4)));
typedef unsigned v2u __attribute__((ext_vector_type(2)));
typedef float f32x4 __attribute__((ext_vector_type(4)));
#define LDS_WAIT() asm volatile("s_waitcnt lgkmcnt(0)" ::: "memory")
__device__ __forceinline__ unsigned f2bf(float f) { unsigned u = __builtin_bit_cast(unsigned, f); return (u + 0x7fffu + ((u >> 16) & 1u)) >> 16; }
__device__ __forceinline__ unsigned pk2(float lo, float hi) { return f2bf(lo) | (f2bf(hi) << 16); }
__device__ __forceinline__ float bf2f(unsigned short b) { return __builtin_bit_cast(float, (unsigned)b << 16); }
__device__ __forceinline__ float bflo(unsigned w) { return __builtin_bit_cast(float, w << 16); }
__device__ __forceinline__ float bfhi(unsigned w) { return __builtin_bit_cast(float, w & 0xffff0000u); }
__device__ __forceinline__ float wave_sum(float v) {
#pragma unroll
    for (int o = 1; o < 64; o <<= 1) v += __shfl_xor(v, o);
    return v;
}

constexpr size_t MiB = 1u << 20;
constexpr size_t MD = (size_t)M * D;
constexpr size_t WS_CTL = 0;
constexpr size_t WS_MOD = 1 * MiB;
constexpr size_t WS_COS = 2 * MiB, WS_SIN = 3 * MiB;
constexpr size_t WS_GATES = 4 * MiB;
constexpr size_t WS_GTAB = 5 * MiB;
constexpr size_t WS_WQKV = 8 * MiB;
constexpr size_t WS_WO = WS_WQKV + (size_t)QKV_W * D * 2;
constexpr size_t WS_WIN = WS_WO + (size_t)D * D * 2;
constexpr size_t WS_WMO = WS_WIN + (size_t)ML_INP * D * 2;
constexpr size_t WS_W1 = WS_WMO + (size_t)D * D * 2;
constexpr size_t WS_W2 = WS_W1 + (size_t)2 * DFF * D * 2;
constexpr size_t WS_H = WS_W2 + (size_t)2 * DFF * D * 2;
constexpr size_t WS_BIG = WS_H + MD * 2;
constexpr size_t WS_AO = WS_BIG + (size_t)M * DFF * 2;
constexpr size_t WS_Z = WS_AO + MD * 2;
constexpr size_t WS_X1 = WS_Z + MD * 4;
constexpr size_t WS_X2 = WS_X1 + MD * 4;
constexpr size_t WS_HZ = WS_X2 + MD * 4;
constexpr size_t WS_S = WS_HZ + 2 * MD * 2;
constexpr size_t WS_END = WS_S + (size_t)BATCH * ML_H * 32 * 64 * 64 * 4;
constexpr int LDS_BYTES = 147456;

struct Args { const float* in[23]; float* out; unsigned char* ws; int ph_lo, ph_hi; };
enum { I_X = 0, I_C, I_POS, I_AWQKV, I_ABQKV, I_ASINK, I_AWO, I_ABO, I_MWIN, I_MBIN, I_MNW, I_MWO, I_MBO, I_MODW, I_MODB, I_W1, I_B1, I_W2, I_B2, I_LNMG, I_LNMB, I_LNFG, I_LNFB };

__device__ __forceinline__ void phase_mod(const Args& a, LAS unsigned char* lds) {
    LAS float* sc = (LAS float*)lds;
    LAS float* red = (LAS float*)(lds + 32768);
    const float* c = a.in[I_C]; const float* mod_w = a.in[I_MODW]; const float* mod_b = a.in[I_MODB];
    float* mod = (float*)(a.ws + WS_MOD);
    const int tid = threadIdx.x, G = gridDim.x;
    for (int i = tid; i < BATCH * D; i += NTHREADS) { const float v = c[i]; sc[i] = v / (1.f + __expf(-v)); }
    __syncthreads();
    const int jj = tid & 31, ks = tid >> 5;
    for (int item = blockIdx.x; item < 2 * (6 * D / 32); item += G) {
        const int l = item / (6 * D / 32), j0 = (item % (6 * D / 32)) * 32;
        const float* w = mod_w + (size_t)l * D * (6 * D) + j0 + jj;
        float a0 = 0.f, a1 = 0.f, a2 = 0.f, a3 = 0.f;
#pragma unroll 16
        for (int k = ks * 128; k < ks * 128 + 128; ++k) { const float wv = w[(size_t)k * (6 * D)]; a0 += sc[k] * wv; a1 += sc[D + k] * wv; a2 += sc[2 * D + k] * wv; a3 += sc[3 * D + k] * wv; }
        red[(ks * 4 + 0) * 32 + jj] = a0; red[(ks * 4 + 1) * 32 + jj] = a1; red[(ks * 4 + 2) * 32 + jj] = a2; red[(ks * 4 + 3) * 32 + jj] = a3;
        __syncthreads();
        if (tid < 128) { const int b = tid >> 5; float s = 0.f;
#pragma unroll
            for (int q = 0; q < 16; ++q) s += red[(q * 4 + b) * 32 + jj];
            mod[((size_t)l * BATCH + b) * (6 * D) + j0 + jj] = s + mod_b[(size_t)l * 6 * D + j0 + jj]; }
        __syncthreads();
    }
    const int* pos = (const int*)a.in[I_POS]; float* cosT = (float*)(a.ws + WS_COS); float* sinT = (float*)(a.ws + WS_SIN);
    for (int i = blockIdx.x * NTHREADS + tid; i < M * 32; i += G * NTHREADS) {
        const int p = i & 31, row = i >> 5;
        const float inv_freq = 1.0f / powf(10000.0f, (float)(2 * p) / 64.0f);
        const float ang = (float)pos[row] * inv_freq;
        cosT[i] = cosf(ang); sinT[i] = sinf(ang);
    }
}

__device__ __forceinline__ void transpose_item(const float* W, int K, int pitch, int nblk, bf16* WT, LAS float* scr, int item, int lane) {
    const int kb = item / nblk, nb = item % nblk, k0 = 64 * kb, n0 = 32 * nb;
#pragma unroll 8
    for (int i = 0; i < 32; ++i) { const int kk = 2 * i + (lane >> 5); scr[kk * 33 + (lane & 31)] = W[(size_t)(k0 + kk) * pitch + n0 + (lane & 31)]; }
    LDS_WAIT(); asm volatile("" ::: "memory");
    const int c = lane & 7;
#pragma unroll
    for (int j = 0; j < 4; ++j) { const int n = (lane >> 3) + 8 * j; const LAS float* s = scr + (8 * c) * 33 + n;
        v4u o; o.x = pk2(s[0 * 33], s[1 * 33]); o.y = pk2(s[2 * 33], s[3 * 33]); o.z = pk2(s[4 * 33], s[5 * 33]); o.w = pk2(s[6 * 33], s[7 * 33]);
        *(v4u*)(WT + (size_t)(n0 + n) * K + k0 + 8 * c) = o; }
    LDS_WAIT(); asm volatile("" ::: "memory");
}
__device__ __forceinline__ void phase_prep(const Args& a, LAS unsigned char* lds) {
    const int tid = threadIdx.x, lane = tid & 63, wave = __builtin_amdgcn_readfirstlane(tid >> 6), G = gridDim.x;
    LAS float* scr = (LAS float*)(lds + wave * 16384);
    const int gw = blockIdx.x * NWAVES + wave, NGW = G * NWAVES;
    constexpr int I0 = (D / 64) * (QKV_W / 32), I1 = (D / 64) * (D / 32), I2 = (D / 64) * (ML_INP / 32), I3 = I1, I4 = (D / 64) * (DFF / 32), I6 = (DFF / 64) * (D / 32);
    constexpr int NITEMS = I0 + I1 + I2 + I3 + 2 * I4 + 2 * I6;
    for (int it = gw; it < NITEMS; it += NGW) {
        int r = it;
        if (r < I0) { transpose_item(a.in[I_AWQKV], D, QKV_W, QKV_W / 32, (bf16*)(a.ws + WS_WQKV), scr, r, lane); continue; } r -= I0;
        if (r < I1) { transpose_item(a.in[I_AWO], D, D, D / 32, (bf16*)(a.ws + WS_WO), scr, r, lane); continue; } r -= I1;
        if (r < I2) { transpose_item(a.in[I_MWIN], D, ML_IN, ML_INP / 32, (bf16*)(a.ws + WS_WIN), scr, r, lane); continue; } r -= I2;
        if (r < I3) { transpose_item(a.in[I_MWO], D, D, D / 32, (bf16*)(a.ws + WS_WMO), scr, r, lane); continue; } r -= I3;
        if (r < 2 * I4) { const int l = r / I4; transpose_item(a.in[I_W1] + (size_t)l * D * DFF, D, DFF, DFF / 32, (bf16*)(a.ws + WS_W1) + (size_t)l * DFF * D, scr, r % I4, lane); continue; } r -= 2 * I4;
        { const int l = r / I6; transpose_item(a.in[I_W2] + (size_t)l * DFF * D, DFF, D, D / 32, (bf16*)(a.ws + WS_W2) + (size_t)l * D * DFF, scr, r % I6, lane); }
    }
    const float* x = a.in[I_X]; const float* mod = (const float*)(a.ws + WS_MOD); bf16* h = (bf16*)(a.ws + WS_H);
    for (size_t i = (size_t)blockIdx.x * NTHREADS + tid; i < MD / 4; i += (size_t)G * NTHREADS) {
        const int row = (int)(i / (D / 4)), c4 = (int)(i % (D / 4)) * 4, b = row / SEQ;
        const f32x4 xv = *(const f32x4*)(x + i * 4), sh = *(const f32x4*)(mod + (size_t)b * 6 * D + c4), sc = *(const f32x4*)(mod + (size_t)b * 6 * D + D + c4);
        const f32x4 hv = xv * (sc + 1.0f) + sh;
        v2u o; o.x = pk2(hv[0], hv[1]); o.y = pk2(hv[2], hv[3]);
        *(v2u*)(h + i * 4) = o;
    }
}

template <bool HAS_H, bool GATES>
__device__ __forceinline__ void phase_ln(const Args& a, LAS unsigned char* lds, const float* z, const float* g, const float* bta, float* xo, const float* modl, int sh_off, int sc_off) {
    const int tid = threadIdx.x, lane = tid & 63, wave = __builtin_amdgcn_readfirstlane(tid >> 6), G = gridDim.x;
    bf16* h = (bf16*)(a.ws + WS_H);
    LAS float* wgt = (LAS float*)lds;
    if (GATES) {
        const float* w_in = a.in[I_MWIN];
        for (int i = tid; i < 16 * D; i += NTHREADS) { const int k = i >> 4, gi = i & 15; wgt[gi * D + k] = w_in[(size_t)k * ML_IN + ML_INP + gi]; }
        __syncthreads();
    }
    const int gw = blockIdx.x * NWAVES + wave, NGW = G * NWAVES;
    for (int row = gw; row < M; row += NGW) {
        const int b = row / SEQ;
        const f32x4* zr = (const f32x4*)(z + (size_t)row * D) + lane;
        f32x4 v[8]; float s = 0.f;
#pragma unroll
        for (int j = 0; j < 8; ++j) { v[j] = zr[64 * j]; s += (v[j][0] + v[j][1]) + (v[j][2] + v[j][3]); }
        const float mean = wave_sum(s) * (1.f / D); float s2 = 0.f;
#pragma unroll
        for (int j = 0; j < 8; ++j) { v[j] = v[j] - mean; s2 += (v[j][0] * v[j][0] + v[j][1] * v[j][1]) + (v[j][2] * v[j][2] + v[j][3] * v[j][3]); }
        const float rstd = 1.0f / sqrtf(wave_sum(s2) * (1.f / D) + LN_EPS);
#pragma unroll
        for (int j = 0; j < 8; ++j) { const int col = 4 * (64 * j + lane);
            v[j] = v[j] * rstd * *(const f32x4*)(g + col) + *(const f32x4*)(bta + col);
            *(f32x4*)(xo + (size_t)row * D + col) = v[j];
            if (HAS_H) { const float* mr = modl + (size_t)b * 6 * D;
                v[j] = v[j] * (*(const f32x4*)(mr + sc_off + col) + 1.0f) + *(const f32x4*)(mr + sh_off + col);
                v2u o; o.x = pk2(v[j][0], v[j][1]); o.y = pk2(v[j][2], v[j][3]);
                *(v2u*)(h + (size_t)row * D + col) = o; } }
        if (GATES) {
            float* gates = (float*)(a.ws + WS_GATES); const float* b_in = a.in[I_MBIN];
            float mine = 0.f;
#pragma unroll 1
            for (int gi = 0; gi < 16; ++gi) { float acc = 0.f;
#pragma unroll
                for (int j = 0; j < 8; ++j) { const f32x4 w = *(const LAS f32x4*)(wgt + gi * D + 4 * (64 * j + lane)); acc += (v[j][0] * w[0] + v[j][1] * w[1]) + (v[j][2] * w[2] + v[j][3] * w[3]); }
                acc = wave_sum(acc); if (lane == gi) mine = acc; }
            if (lane < 16) gates[(size_t)row * 16 + lane] = mine + b_in[ML_INP + lane];
        }
    }
    if (GATES) __syncthreads();
}

__device__ __forceinline__ void phase_headnorm(const Args& a) {
    const int tid = threadIdx.x, lane = tid & 63, wave = __builtin_amdgcn_readfirstlane(tid >> 6), G = gridDim.x;
    const bf16* hz = (const bf16*)(a.ws + WS_HZ); const bf16* proj = (const bf16*)(a.ws + WS_BIG); bf16* ym = (bf16*)(a.ws + WS_AO); const float* nw = a.in[I_MNW];
    const int gw = blockIdx.x * NWAVES + wave, NGW = G * NWAVES;
    for (int it = gw; it < M * ML_H; it += NGW) {
        const int row = it >> 2, hh = it & 3; const size_t off = (size_t)row * D + hh * ML_DV + lane * 8;
        const v4u f = *(const v4u*)(hz + off), bw = *(const v4u*)(hz + MD + off), ov = *(const v4u*)(proj + (size_t)row * ML_INP + 4096 + hh * ML_DV + lane * 8);
        float v[8]; float s = 0.f;
#pragma unroll
        for (int e = 0; e < 4; ++e) { v[2 * e] = bflo(f[e]) + bflo(bw[e]); v[2 * e + 1] = bfhi(f[e]) + bfhi(bw[e]); s += v[2 * e] + v[2 * e + 1]; }
        const float mean = wave_sum(s) * (1.f / ML_DV); float s2 = 0.f;
#pragma unroll
        for (int e = 0; e < 8; ++e) { v[e] -= mean; s2 += v[e] * v[e]; }
        const float rstd = 1.0f / sqrtf(wave_sum(s2) * (1.f / ML_DV) + HN_EPS);
        const f32x4 w0 = *(const f32x4*)(nw + hh * ML_DV + lane * 8), w1 = *(const f32x4*)(nw + hh * ML_DV + lane * 8 + 4);
        float y[8];
#pragma unroll
        for (int e = 0; e < 8; ++e) { const float og = (e & 1) ? bfhi(ov[e >> 1]) : bflo(ov[e >> 1]); const float wv = e < 4 ? w0[e] : w1[e - 4];
            y[e] = (1.f / (1.f + __expf(-og))) * (v[e] * rstd * wv); }
        v4u o; o.x = pk2(y[0], y[1]); o.y = pk2(y[2], y[3]); o.z = pk2(y[4], y[5]); o.w = pk2(y[6], y[7]);
        *(v4u*)(ym + off) = o;
    }
}

__global__ void __launch_bounds__(64) attn_base(const bf16* __restrict__ qkv, const float* __restrict__ sink, bf16* __restrict__ o) {
    const int b = blockIdx.z, h = blockIdx.y, q0 = blockIdx.x * 64, qi = q0 + threadIdx.x, kvh = h / 4;
    const bf16* qrow = qkv + ((size_t)b * SEQ + qi) * QKV_W + h * 64;
    float q[64], acc[64];
#pragma unroll
    for (int d = 0; d < 64; ++d) { q[d] = bf2f(qrow[d]); acc[d] = 0.f; }
    float m = sink[h] * LOG2E, l = 1.f;
    int klo = q0 - 128; if (klo < 0) klo = 0; int khi = q0 + 63 + 128; if (khi > SEQ - 1) khi = SEQ - 1;
    for (int kp = klo; kp <= khi; ++kp) {
        const bf16* krow = qkv + ((size_t)b * SEQ + kp) * QKV_W + 2048 + kvh * 64;
        const bf16* vrow = krow + 512;
        float s = 0.f;
#pragma unroll
        for (int d = 0; d < 64; ++d) s += q[d] * bf2f(krow[d]);
        int dd = kp - qi; if (dd < 0) dd = -dd;
        if (dd <= 128) {
            const float mn = fmaxf(m, s), f = exp2f(m - mn), p = exp2f(s - mn);
            l = l * f + p;
#pragma unroll
            for (int d = 0; d < 64; ++d) acc[d] = acc[d] * f + p * bf2f(vrow[d]);
            m = mn;
        }
    }
    bf16* orow = o + ((size_t)b * SEQ + qi) * D + h * 64;
    const float il = 1.f / l;
#pragma unroll
    for (int d = 0; d < 64; ++d) orow[d] = (bf16)f2bf(acc[d] * il);
}

__global__ void __launch_bounds__(256) mlstm_base(const bf16* __restrict__ proj, const float* __restrict__ gates, bf16* __restrict__ hz) {
    __shared__ float qs[256], ks[256], vs[64], part[2][4][64];
    const int sl = blockIdx.x, h = blockIdx.y, z = blockIdx.z, dir = z / BATCH, b = z % BATCH;
    const int tid = threadIdx.x, dv = tid & 63, dkq = tid >> 6;
    float C[64], n[64];
#pragma unroll
    for (int j = 0; j < 64; ++j) { C[j] = 0.f; n[j] = 0.f; }
    float m = -1e30f;
    bf16* out = hz + (size_t)dir * MD;
    for (int step = 0; step < SEQ; ++step) {
        const int t = dir ? (SEQ - 1 - step) : step;
        const bf16* pr = proj + ((size_t)b * SEQ + t) * ML_INP;
        const float* gr = gates + ((size_t)b * SEQ + t) * 16;
        qs[tid] = bf2f(pr[h * ML_DK + tid]); ks[tid] = bf2f(pr[1024 + h * ML_DK + tid]);
        if (tid < 64) vs[tid] = bf2f(pr[2048 + h * ML_DV + sl * 64 + tid]);
        const float li = gr[(dir ? 8 : 0) + h], fp = gr[(dir ? 12 : 4) + h];
        const float lf = fminf(fp, 0.f) - log1pf(expf(-fabsf(fp)));
        const float mn = fmaxf(lf + m, li), fd = expf(lf + m - mn), fi = expf(li - mn);
        m = mn;
        __syncthreads();
        const float kv = fi * vs[dv];
        float pn = 0.f, pd = 0.f;
#pragma unroll
        for (int j = 0; j < 64; ++j) { const float kk = ks[dkq * 64 + j], qq = qs[dkq * 64 + j];
            C[j] = fd * C[j] + kk * kv; n[j] = fd * n[j] + fi * kk; pn += qq * C[j]; pd += qq * n[j]; }
        part[0][dkq][dv] = pn; part[1][dkq][dv] = pd;
        __syncthreads();
        if (tid < 64) { const float num = part[0][0][tid] + part[0][1][tid] + part[0][2][tid] + part[0][3][tid];
            const float den = part[1][0][tid] + part[1][1][tid] + part[1][2][tid] + part[1][3][tid];
            out[((size_t)b * SEQ + t) * D + h * ML_DV + sl * 64 + tid] = (bf16)f2bf(num / fmaxf(fabsf(den), expf(-mn))); }
        __syncthreads();
    }
}

namespace cg = cooperative_groups;
__global__ void __launch_bounds__(NTHREADS, 2) mega(Args a) {
    extern __shared__ __attribute__((aligned(16))) unsigned char lds_raw[];
    LAS unsigned char* lds = (LAS unsigned char*)lds_raw;
    cg::grid_group grid = cg::this_grid();
    const int lo = a.ph_lo, hi = a.ph_hi, G = gridDim.x;
#define IN(k) (lo <= (k) && (k) < hi)
#define SEAM(k) do { if (IN(k) && IN((k) + 1)) grid.sync(); } while (0)
    unsigned char* ws = a.ws;
    const float* mod0 = (const float*)(ws + WS_MOD); const float* mod1 = mod0 + (size_t)BATCH * 6 * D;
    bf16* Hb = (bf16*)(ws + WS_H); bf16* BIG = (bf16*)(ws + WS_BIG); bf16* AO = (bf16*)(ws + WS_AO);
    float* Z = (float*)(ws + WS_Z); float* X1 = (float*)(ws + WS_X1); float* X2 = (float*)(ws + WS_X2);

    if (IN(0)) { phase_mod(a, lds); } SEAM(0);
    if (IN(1)) { phase_prep(a, lds); } SEAM(1);
    if (IN(2)) {
        pg8::Gemm g{Hb, (const bf16*)(ws + WS_WQKV), M, QKV_W, D}; pg8::StaticOrder S; S.init(M, QKV_W, G, (int)blockIdx.x);
        pg8::EpiQKV E{BIG, QKV_W, a.in[I_ABQKV], (const float*)(ws + WS_COS), (const float*)(ws + WS_SIN), 8, 10, QSCALE};
        pg8::gemm_phase<pg8::EpiQKV, pg8::StaticOrder, true, true>(lds, g, S, E);
    } SEAM(2);
    if (IN(3)) {   } SEAM(3);
    if (IN(4)) {
        pg8::Gemm g{AO, (const bf16*)(ws + WS_WO), M, D, D}; pg8::StaticOrder S; S.init(M, D, G, (int)blockIdx.x);
        pg8::EpiRes E{Z, D, a.in[I_ABO], a.in[I_X], mod0 + 2 * D, 6 * D, SEQ / 256, ALPHA};
        pg8::gemm_phase<pg8::EpiRes, pg8::StaticOrder, true, true>(lds, g, S, E);
    } SEAM(4);
    if (IN(5)) { phase_ln<true, false>(a, lds, Z, a.in[I_LNMG], a.in[I_LNMB], X1, mod0, 3 * D, 4 * D); } SEAM(5);
    if (IN(6)) {
        pg8::Gemm g{Hb, (const bf16*)(ws + WS_W1), M, DFF, D}; pg8::StaticOrder S; S.init(M, DFF, G, (int)blockIdx.x);
        pg8::EpiBf16<1> E{BIG, DFF, a.in[I_B1], 0, 1.f};
        pg8::gemm_phase<pg8::EpiBf16<1>, pg8::StaticOrder, true, true>(lds, g, S, E);
    } SEAM(6);
    if (IN(7)) {
        pg8::Gemm g{BIG, (const bf16*)(ws + WS_W2), M, D, DFF}; pg8::StaticOrder S; S.init(M, D, G, (int)blockIdx.x);
        pg8::EpiRes E{Z, D, a.in[I_B2], X1, mod0 + 5 * D, 6 * D, SEQ / 256, ALPHA};
        pg8::gemm_phase<pg8::EpiRes, pg8::StaticOrder, true, true>(lds, g, S, E);
    } SEAM(7);
    if (IN(8)) { phase_ln<true, true>(a, lds, Z, a.in[I_LNFG], a.in[I_LNFB], X2, mod1, 0, D); } SEAM(8);
    if (IN(9)) {
        pg8::Gemm g{Hb, (const bf16*)(ws + WS_WIN), M, ML_INP, D}; pg8::StaticOrder S; S.init(M, ML_INP, G, (int)blockIdx.x);
        pg8::EpiBf16<0> E{BIG, ML_INP, a.in[I_MBIN], 4, 0.0625f};
        pg8::gemm_phase<pg8::EpiBf16<0>, pg8::StaticOrder, true, true>(lds, g, S, E);
    } SEAM(9);
    if (IN(10)) {   } SEAM(10);
    if (IN(11)) {   } SEAM(11);
    if (IN(12)) { phase_headnorm(a); } SEAM(12);
    if (IN(13)) {
        pg8::Gemm g{AO, (const bf16*)(ws + WS_WMO), M, D, D}; pg8::StaticOrder S; S.init(M, D, G, (int)blockIdx.x);
        pg8::EpiRes E{Z, D, a.in[I_MBO], X2, mod1 + 2 * D, 6 * D, SEQ / 256, ALPHA};
        pg8::gemm_phase<pg8::EpiRes, pg8::StaticOrder, true, true>(lds, g, S, E);
    } SEAM(13);
    if (IN(14)) { phase_ln<true, false>(a, lds, Z, a.in[I_LNMG] + D, a.in[I_LNMB] + D, X1, mod1, 3 * D, 4 * D); } SEAM(14);
    if (IN(15)) {
        pg8::Gemm g{Hb, (const bf16*)(ws + WS_W1) + (size_t)DFF * D, M, DFF, D}; pg8::StaticOrder S; S.init(M, DFF, G, (int)blockIdx.x);
        pg8::EpiBf16<1> E{BIG, DFF, a.in[I_B1] + DFF, 0, 1.f};
        pg8::gemm_phase<pg8::EpiBf16<1>, pg8::StaticOrder, true, true>(lds, g, S, E);
    } SEAM(15);
    if (IN(16)) {
        pg8::Gemm g{BIG, (const bf16*)(ws + WS_W2) + (size_t)D * DFF, M, D, DFF}; pg8::StaticOrder S; S.init(M, D, G, (int)blockIdx.x);
        pg8::EpiRes E{Z, D, a.in[I_B2] + D, X1, mod1 + 5 * D, 6 * D, SEQ / 256, ALPHA};
        pg8::gemm_phase<pg8::EpiRes, pg8::StaticOrder, true, true>(lds, g, S, E);
    } SEAM(16);
    if (IN(17)) { phase_ln<false, false>(a, lds, Z, a.in[I_LNFG] + D, a.in[I_LNFB] + D, a.out, nullptr, 0, 0); }
#undef IN
#undef SEAM
}

extern "C" void kernel_launch(void* const* d_in, const int* in_sizes, int n_in, void* d_out, int out_size, void* d_ws, size_t ws_size, hipStream_t stream) {
    static int grid = 0;
    if (grid == 0) {
        if (n_in != 23 || ws_size < WS_END) { fprintf(stderr, "kernel_launch: need 23 inputs and %zu bytes of workspace; got %d, %zu\n", (size_t)WS_END, n_in, ws_size); grid = -1; return; }
        int dev = 0, cus = 0, per_cu = 0;
        hipGetDevice(&dev); hipDeviceGetAttribute(&cus, hipDeviceAttributeMultiprocessorCount, dev);
        if (hipFuncSetAttribute((const void*)mega, hipFuncAttributeMaxDynamicSharedMemorySize, LDS_BYTES) != hipSuccess) { fprintf(stderr, "kernel_launch: hipFuncSetAttribute failed\n"); grid = -1; return; }
        hipOccupancyMaxActiveBlocksPerMultiprocessor(&per_cu, (const void*)mega, NTHREADS, LDS_BYTES);
        (void)hipGetLastError();
        if (per_cu < 1) { fprintf(stderr, "kernel_launch: occupancy query says %d blocks per CU\n", per_cu); per_cu = 1; }
        grid = cus;
    }
    if (grid < 0) return;
    Args a{};
    for (int i = 0; i < 23; ++i) a.in[i] = (const float*)d_in[i];
    a.out = (float*)d_out; a.ws = (unsigned char*)d_ws;
    auto run = [&](int lo, int hi) { a.ph_lo = lo; a.ph_hi = hi; hipLaunchKernelGGL(mega, dim3(grid), dim3(NTHREADS), LDS_BYTES, stream, a); };
    unsigned char* ws = (unsigned char*)d_ws;
    run(0, 1); run(1, 2); run(2, 3);
    attn_base<<<dim3(SEQ / 64, NQH, BATCH), 64, 0, stream>>>((const bf16*)(ws + WS_BIG), (const float*)d_in[I_ASINK], (bf16*)(ws + WS_AO));
    run(4, 5); run(5, 6); run(6, 7); run(7, 8); run(8, 9); run(9, 10);
    mlstm_base<<<dim3(8, ML_H, 2 * BATCH), 256, 0, stream>>>((const bf16*)(ws + WS_BIG), (const float*)(ws + WS_GATES), (bf16*)(ws + WS_HZ));
    run(12, 13); run(13, 14); run(14, 15); run(15, 16); run(16, 17); run(17, 18);
}
```

```cpp
#include <hip/hip_runtime.h>
#include <hip/hip_cooperative_groups.h>
#include <cstdio>
#include <cstdint>
#include <cmath>

constexpr int D = 2048, BATCH = 4, SEQ = 2048, M = BATCH * SEQ;
constexpr int QKV_W = 3072, NQH = 32, NKVH = 8;
constexpr int ML_H = 4, ML_DV = 512, ML_DK = 256, ML_IN = 6160, ML_INP = 6144;
constexpr int DFF = 8192;
constexpr float ALPHA = 1.4142135623730951f;
constexpr float LN_EPS = 1e-5f, HN_EPS = 1e-6f;
constexpr float LOG2E = 1.4426950408889634f;
constexpr float QSCALE = 0.125f * LOG2E;
constexpr int NWAVES = 8, NTHREADS = 512;

namespace pg8 {
#define PG8_LAS __attribute__((address_space(3)))
typedef unsigned short bf16_t;
typedef short bf16x8 __attribute__((ext_vector_type(8)));
typedef float f32x4 __attribute__((ext_vector_type(4)));
typedef unsigned u32x4 __attribute__((ext_vector_type(4)));
constexpr int BM = 256, BK = 64, HALF = 128, HTB = HALF * BK * 2  , STAGE_BYTES = 8 * HTB, NXCD = 8, WGM = 8;

__host__ __device__ __forceinline__ int lds_byte(int r, int c) { const int st = (r >> 4) * 2 + (c >> 5), rr = r & 15, cc = c & 31, ob = rr * 64 + cc * 2; return st * 1024 + (ob ^ (((ob >> 9) & 1) << 5)); }
__host__ __device__ __forceinline__ void stage_rc(int b, int& R, int& C) { const int st = b / 1024, sb = b % 1024, swz = sb ^ (((sb >> 9) & 1) << 5); R = (st >> 1) * 16 + swz / 64; C = (st & 1) * 32 + (swz % 64) / 2; }
__host__ __device__ __forceinline__ int perm32(int rho) { const int n = rho >> 4, i = rho & 15; return 8 * (i >> 2) + 4 * n + (i & 3); }

struct Unit { int pm, pn; };
struct Gemm { const bf16_t* A; const bf16_t* Bt; int M, N, K; };

struct StaticOrder {
    int nM, nN, nwg, G, c;
    __host__ __device__ void init(int M, int N, int G_, int c_) { nM = M / BM; nN = N / BM; nwg = nM * nN; G = G_; c = c_; }
    __host__ __device__ bool next(int i, Unit& u) const {
        const long L = (long)i * G + c; if (L >= nwg) return false;
        int wgid = (int)L; { const int q = nwg / NXCD, r = nwg % NXCD, xcd = wgid % NXCD, off = wgid / NXCD; wgid = (xcd < r ? xcd * (q + 1) : r * (q + 1) + (xcd - r) * q) + off; }
        const int nig = WGM * nN, gid = wgid / nig, fm = gid * WGM, gsz = (nM - fm) < WGM ? (nM - fm) : WGM;
        u.pm = fm + ((wgid % nig) % gsz); u.pn = (wgid % nig) / gsz; return true;
    }
    __device__ __forceinline__ void a_ready(const Unit&) const {}
    __device__ __forceinline__ void done(const Unit&) const {}
};

__device__ __forceinline__ unsigned cvt_pk_bf16(float lo, float hi) { unsigned r; asm volatile("v_cvt_pk_bf16_f32 %0, %1, %2" : "=v"(r) : "v"(lo), "v"(hi)); return r; }

template <int ACT> struct EpiBf16 {
    static constexpr int PERM = 1; static constexpr bool AFTER_DRAIN = false;
    bf16_t* O; int ldc; const float* bias; int npn0; float scale0;
    __device__ __forceinline__ void operator()(const f32x4 (&acc)[2][2][4][2], const Unit& u, int wr, int wc, int fr, int fq) const {
        const int row0 = u.pm * BM + wr * 64 + fr, col0 = u.pn * BM + wc * 32 + 8 * fq;
        const float sc = (u.pn < npn0) ? scale0 : 1.f;
        f32x4 bv[2][2];
#pragma unroll
        for (int bj = 0; bj < 2; ++bj)
#pragma unroll
            for (int n = 0; n < 2; ++n) bv[bj][n] = *(const f32x4*)(bias + col0 + bj * HALF + 4 * n);
#pragma unroll
        for (int ai = 0; ai < 2; ++ai)
#pragma unroll
            for (int m = 0; m < 4; ++m) { bf16_t* rowp = O + (size_t)(row0 + ai * HALF + m * 16) * ldc + col0;
#pragma unroll
                for (int bj = 0; bj < 2; ++bj) { f32x4 v0 = acc[ai][bj][m][0] + bv[bj][0], v1 = acc[ai][bj][m][1] + bv[bj][1];
                    if (ACT == 1) {
#pragma unroll
                        for (int e = 0; e < 4; ++e) { float a = v0[e] > 0.f ? v0[e] : 0.f, b = v1[e] > 0.f ? v1[e] : 0.f; v0[e] = a * a; v1[e] = b * b; } }
                    v0 = v0 * sc; v1 = v1 * sc; u32x4 w; w.x = cvt_pk_bf16(v0[0], v0[1]); w.y = cvt_pk_bf16(v0[2], v0[3]); w.z = cvt_pk_bf16(v1[0], v1[1]); w.w = cvt_pk_bf16(v1[2], v1[3]);
                    *(u32x4*)(rowp + bj * HALF) = w; } }
    }
};

struct EpiQKV {
    static constexpr int PERM = 2; static constexpr bool AFTER_DRAIN = false;
    bf16_t* O; int ldc; const float* bias; const float* cosT; const float* sinT; int npn_q, npn_rope; float qscale;
    __device__ __forceinline__ void operator()(const f32x4 (&acc)[2][2][4][2], const Unit& u, int wr, int wc, int fr, int fq) const {
        const int row0 = u.pm * BM + wr * 64 + fr, col0 = u.pn * BM + wc * 64 + 8 * fq;
        const float sc = (u.pn < npn_q) ? qscale : 1.f; const bool rope = u.pn < npn_rope;
        f32x4 bv[2][2];
#pragma unroll
        for (int bj = 0; bj < 2; ++bj)
#pragma unroll
            for (int n = 0; n < 2; ++n) bv[bj][n] = *(const f32x4*)(bias + col0 + bj * 32 + 4 * n);
#pragma unroll
        for (int ai = 0; ai < 2; ++ai)
#pragma unroll
            for (int m = 0; m < 4; ++m) { const int row = row0 + ai * HALF + m * 16; bf16_t* rowp = O + (size_t)row * ldc + col0;
                f32x4 lo0 = acc[ai][0][m][0] + bv[0][0], lo1 = acc[ai][0][m][1] + bv[0][1], hi0 = acc[ai][1][m][0] + bv[1][0], hi1 = acc[ai][1][m][1] + bv[1][1];
                if (rope) { const f32x4 c0 = *(const f32x4*)(cosT + (size_t)row * 32 + 8 * fq), c1 = *(const f32x4*)(cosT + (size_t)row * 32 + 8 * fq + 4);
                    const f32x4 s0 = *(const f32x4*)(sinT + (size_t)row * 32 + 8 * fq), s1 = *(const f32x4*)(sinT + (size_t)row * 32 + 8 * fq + 4);
                    const f32x4 a0 = lo0 * c0 - hi0 * s0, a1 = lo1 * c1 - hi1 * s1, b0 = hi0 * c0 + lo0 * s0, b1 = hi1 * c1 + lo1 * s1;
                    lo0 = a0; lo1 = a1; hi0 = b0; hi1 = b1; }
                lo0 = lo0 * sc; lo1 = lo1 * sc; hi0 = hi0 * sc; hi1 = hi1 * sc;
                u32x4 w; w.x = cvt_pk_bf16(lo0[0], lo0[1]); w.y = cvt_pk_bf16(lo0[2], lo0[3]); w.z = cvt_pk_bf16(lo1[0], lo1[1]); w.w = cvt_pk_bf16(lo1[2], lo1[3]);
                *(u32x4*)(rowp) = w;
                w.x = cvt_pk_bf16(hi0[0], hi0[1]); w.y = cvt_pk_bf16(hi0[2], hi0[3]); w.z = cvt_pk_bf16(hi1[0], hi1[1]); w.w = cvt_pk_bf16(hi1[2], hi1[3]);
                *(u32x4*)(rowp + 32) = w; }
    }
};

struct EpiRes {
    static constexpr int PERM = 1; static constexpr bool AFTER_DRAIN = false;
    float* Z; int ldc; const float* bias; const float* res; const float* gate; int gate_ld; int tiles_per_batch; float alpha;
    __device__ __forceinline__ void operator()(const f32x4 (&acc)[2][2][4][2], const Unit& u, int wr, int wc, int fr, int fq) const {
        const int row0 = u.pm * BM + wr * 64 + fr, col0 = u.pn * BM + wc * 32 + 8 * fq;
        const float* gp = gate + (size_t)(u.pm / tiles_per_batch) * gate_ld;
        f32x4 bv[2][2], gv[2][2];
#pragma unroll
        for (int bj = 0; bj < 2; ++bj)
#pragma unroll
            for (int n = 0; n < 2; ++n) { bv[bj][n] = *(const f32x4*)(bias + col0 + bj * HALF + 4 * n); gv[bj][n] = *(const f32x4*)(gp + col0 + bj * HALF + 4 * n) + 1.0f; }
#pragma unroll
        for (int ai = 0; ai < 2; ++ai)
#pragma unroll
            for (int m = 0; m < 4; ++m) { const size_t off = (size_t)(row0 + ai * HALF + m * 16) * ldc + col0;
#pragma unroll
                for (int bj = 0; bj < 2; ++bj)
#pragma unroll
                    for (int n = 0; n < 2; ++n) { const f32x4 r = *(const f32x4*)(res + off + bj * HALF + 4 * n);
                        *(f32x4*)(Z + off + bj * HALF + 4 * n) = r * alpha + gv[bj][n] * (acc[ai][bj][m][n] + bv[bj][n]); }
                asm volatile("" ::: "memory"); }
    }
};

template <class Epi, class Sched, bool ALIGN_EPI = false, bool SP2 = false>
__device__ __forceinline__ void gemm_phase(PG8_LAS unsigned char* lds, const Gemm g, const Sched& S, const Epi& E) {
    const int tid = threadIdx.x, wid = __builtin_amdgcn_readfirstlane(tid >> 6), lane = tid & 63, wr = wid >> 2, wc = wid & 3, fr = lane & 15, fq = lane >> 4;
    const int K = g.K, nt = K / BK;
    unsigned voffA[2], voffB[2];
#pragma unroll
    for (int i = 0; i < 2; ++i) { int R, C; stage_rc(tid * 16 + i * 8192, R, C); const int Rb = (Epi::PERM == 2) ? (64 * (R >> 5) + perm32(R & 31)) : (Epi::PERM == 1) ? ((R & ~31) + perm32(R & 31)) : R;
        voffA[i] = (unsigned)(R * K + C) * 2u; voffB[i] = (unsigned)(Rb * K + C) * 2u; }
    const size_t kstep = (size_t)(BK * 2);
    const size_t hstep = (size_t)HALF * K * 2;
    const size_t tstep = 2 * hstep;
    const size_t bhstep = (Epi::PERM == 2) ? (size_t)32 * K * 2 : hstep;
    const unsigned ldsw = (unsigned)wid * 1024u;
    const int aoff = lds_byte(wr * 64 + fr, fq * 8), boff = lds_byte(wc * 32 + fr, fq * 8);
#define PG8_SA(b, h) (((b) * 2 + (h)) * HTB)
#define PG8_SB(b, h) ((4 + (b) * 2 + (h)) * HTB)
#define PG8_STAGE(bufoff, gbase, voff) do { _Pragma("unroll") for (int _i = 0; _i < 2; ++_i) \
        __builtin_amdgcn_global_load_lds((const unsigned*)((const char*)(gbase) + (voff)[_i]), (PG8_LAS unsigned*)(lds + (bufoff) + ldsw + _i * 8192), 16, 0, 0); } while (0)
#define PG8_LDA(dst, b, h) do { _Pragma("unroll") for (int m = 0; m < 4; ++m) _Pragma("unroll") for (int k = 0; k < 2; ++k) dst[m][k] = *(const PG8_LAS bf16x8*)(lds + PG8_SA(b, h) + aoff + m * 2048 + k * 1024); } while (0)
#define PG8_LDB(dst, b, h) do { _Pragma("unroll") for (int n = 0; n < 2; ++n) _Pragma("unroll") for (int k = 0; k < 2; ++k) dst[n][k] = *(const PG8_LAS bf16x8*)(lds + PG8_SB(b, h) + boff + n * 2048 + k * 1024); } while (0)
#define PG8_MMA(ai, bj, At, Bt) do { __builtin_amdgcn_s_setprio(1); _Pragma("unroll") for (int m = 0; m < 4; ++m) _Pragma("unroll") for (int n = 0; n < 2; ++n) _Pragma("unroll") for (int k = 0; k < 2; ++k) \
        acc[ai][bj][m][n] = __builtin_amdgcn_mfma_f32_16x16x32_bf16(Bt[n][k], At[m][k], acc[ai][bj][m][n], 0, 0, 0); __builtin_amdgcn_s_setprio(0); } while (0)
#define PG8_WAIT_V(n) asm volatile("s_waitcnt vmcnt(" #n ")" ::: "memory")
#define PG8_WAIT_L(n) asm volatile("s_waitcnt lgkmcnt(" #n ")" ::: "memory")
#define PG8_BAR __builtin_amdgcn_s_barrier()
#define PG8_SCHED __builtin_amdgcn_sched_barrier(0)
    Unit cur, nxt; int ui = 0;
    if (!S.next(0, cur)) return;
    f32x4 acc[2][2][4][2];
#pragma unroll
    for (int a = 0; a < 2; ++a)
#pragma unroll
        for (int b = 0; b < 2; ++b)
#pragma unroll
            for (int m = 0; m < 4; ++m)
#pragma unroll
                for (int n = 0; n < 2; ++n) acc[a][b][m][n] = (f32x4){0.f, 0.f, 0.f, 0.f};
    bf16x8 At[4][2], B0[2][2], B1[2][2];
    const char* cA = (const char*)g.A + (size_t)cur.pm * tstep; const char* cB = (const char*)g.Bt + (size_t)cur.pn * tstep;
    S.a_ready(cur);
    if constexpr (SP2) {
        PG8_STAGE(PG8_SB(0, 0), cB, voffB); PG8_STAGE(PG8_SB(0, 1), cB + bhstep, voffB); PG8_STAGE(PG8_SA(0, 0), cA, voffA); PG8_STAGE(PG8_SA(0, 1), cA + hstep, voffA);
        if (wr == 1) PG8_BAR;
        PG8_WAIT_V(2); PG8_BAR;
        PG8_STAGE(PG8_SB(1, 0), cB + kstep, voffB); PG8_STAGE(PG8_SA(1, 0), cA + kstep, voffA); PG8_STAGE(PG8_SB(1, 1), cB + bhstep + kstep, voffB);
        PG8_WAIT_V(6); PG8_BAR;
    } else {
        PG8_STAGE(PG8_SB(0, 0), cB, voffB); PG8_STAGE(PG8_SA(0, 0), cA, voffA); PG8_STAGE(PG8_SB(0, 1), cB + bhstep, voffB); PG8_STAGE(PG8_SA(0, 1), cA + hstep, voffA);
        if (wr == 1) PG8_BAR;
        PG8_WAIT_V(4); PG8_BAR;
        PG8_STAGE(PG8_SB(1, 0), cB + kstep, voffB); PG8_STAGE(PG8_SA(1, 0), cA + kstep, voffA); PG8_STAGE(PG8_SB(1, 1), cB + bhstep + kstep, voffB);
        PG8_WAIT_V(6); PG8_BAR;
    }
    for (;;) {
        const bool has_next = S.next(ui + 1, nxt);
        const char* nA = has_next ? (const char*)g.A + (size_t)nxt.pm * tstep : cA; const char* nB = has_next ? (const char*)g.Bt + (size_t)nxt.pn * tstep : cB;
        for (int t = 0; t < nt; t += 2) {
            const bool last = (t == nt - 2);
            const char* a1 = cA + (size_t)(t + 1) * kstep;
            const char* a2 = last ? nA : cA + (size_t)(t + 2) * kstep; const char* b2 = last ? nB : cB + (size_t)(t + 2) * kstep;
            const char* a3 = a2 + kstep; const char* b3 = b2 + kstep;
            if (last && has_next) S.a_ready(nxt);
            if constexpr (SP2) {
            PG8_LDB(B0, 0, 0); PG8_LDB(B1, 0, 1); PG8_SCHED; PG8_LDA(At, 0, 0); PG8_STAGE(PG8_SA(1, 1), a1 + hstep, voffA);
            PG8_WAIT_V(8); PG8_WAIT_L(0); PG8_BAR; PG8_MMA(0, 0, At, B0); PG8_MMA(0, 1, At, B1); PG8_BAR; PG8_SCHED;
            PG8_LDA(At, 0, 1); PG8_STAGE(PG8_SB(0, 0), b2, voffB); PG8_STAGE(PG8_SB(0, 1), b2 + bhstep, voffB); PG8_STAGE(PG8_SA(0, 0), a2, voffA);
            PG8_WAIT_V(8); PG8_WAIT_L(0); PG8_BAR; PG8_MMA(1, 0, At, B0); PG8_MMA(1, 1, At, B1); PG8_BAR; PG8_SCHED;
            PG8_LDB(B0, 1, 0); PG8_LDB(B1, 1, 1); PG8_SCHED; PG8_LDA(At, 1, 0); PG8_STAGE(PG8_SA(0, 1), a2 + hstep, voffA);
            PG8_WAIT_V(8); PG8_WAIT_L(0); PG8_BAR; PG8_MMA(0, 0, At, B0); PG8_MMA(0, 1, At, B1); PG8_BAR; PG8_SCHED;
            PG8_LDA(At, 1, 1); PG8_STAGE(PG8_SB(1, 0), b3, voffB); PG8_STAGE(PG8_SB(1, 1), b3 + bhstep, voffB); PG8_STAGE(PG8_SA(1, 0), a3, voffA);
            PG8_WAIT_V(8); PG8_WAIT_L(0); PG8_BAR; PG8_MMA(1, 0, At, B0); PG8_MMA(1, 1, At, B1); PG8_BAR; PG8_SCHED;
            } else {
            PG8_LDB(B0, 0, 0); PG8_SCHED; PG8_LDA(At, 0, 0); PG8_STAGE(PG8_SA(1, 1), a1 + hstep, voffA);
            PG8_WAIT_L(8); PG8_BAR; PG8_WAIT_L(0); PG8_MMA(0, 0, At, B0); PG8_BAR; PG8_SCHED;
            PG8_LDB(B1, 0, 1); PG8_STAGE(PG8_SB(0, 0), b2, voffB);
            PG8_BAR; PG8_WAIT_L(0); PG8_MMA(0, 1, At, B1); PG8_BAR;
            PG8_LDA(At, 0, 1); PG8_STAGE(PG8_SA(0, 0), a2, voffA);
            PG8_BAR; PG8_WAIT_L(0); PG8_MMA(1, 0, At, B0); PG8_BAR; PG8_SCHED;
            PG8_STAGE(PG8_SB(0, 1), b2 + bhstep, voffB);
            PG8_WAIT_V(6); PG8_BAR; PG8_MMA(1, 1, At, B1); PG8_BAR;
            PG8_LDB(B0, 1, 0); PG8_SCHED; PG8_LDA(At, 1, 0); PG8_STAGE(PG8_SA(0, 1), a2 + hstep, voffA);
            PG8_WAIT_L(8); PG8_BAR; PG8_WAIT_L(0); PG8_MMA(0, 0, At, B0); PG8_BAR; PG8_SCHED;
            PG8_LDB(B1, 1, 1); PG8_STAGE(PG8_SB(1, 0), b3, voffB);
            PG8_BAR; PG8_WAIT_L(0); PG8_MMA(0, 1, At, B1); PG8_BAR;
            PG8_LDA(At, 1, 1); PG8_STAGE(PG8_SA(1, 0), a3, voffA);
            PG8_BAR; PG8_WAIT_L(0); PG8_MMA(1, 0, At, B0); PG8_BAR; PG8_SCHED;
            PG8_STAGE(PG8_SB(1, 1), b3 + bhstep, voffB);
            PG8_WAIT_V(6); PG8_BAR; PG8_MMA(1, 1, At, B1); PG8_BAR;
            }
        }
        if constexpr (ALIGN_EPI) { if (wr == 0) PG8_BAR; }
        if constexpr (!Epi::AFTER_DRAIN) { E(acc, cur, wr, wc, fr, fq); S.done(cur); }
        if (!has_next) break;
#pragma unroll
        for (int a = 0; a < 2; ++a)
#pragma unroll
            for (int b = 0; b < 2; ++b)
#pragma unroll
                for (int m = 0; m < 4; ++m)
#pragma unroll
                    for (int n = 0; n < 2; ++n) acc[a][b][m][n] = (f32x4){0.f, 0.f, 0.f, 0.f};
        cur = nxt; cA = nA; cB = nB; ++ui;
        if constexpr (ALIGN_EPI) { if (wr == 1) PG8_BAR; }
    }
    PG8_WAIT_V(0);
    if constexpr (!ALIGN_EPI) { if (wr == 0) PG8_BAR; }
    PG8_BAR;
    if constexpr (Epi::AFTER_DRAIN) { E.fused(acc, cur, wr, wc, fr, fq, lds, wid, lane); S.done(cur); }
#undef PG8_SA
#undef PG8_SB
#undef PG8_STAGE
#undef PG8_LDA
#undef PG8_LDB
#undef PG8_MMA
#undef PG8_WAIT_V
#undef PG8_WAIT_L
#undef PG8_BAR
#undef PG8_SCHED
}
}

#define LAS __attribute__((address_space(3)))
typedef unsigned short bf16;
typedef unsigned v4u __attribute__((ext_vector_type(4)));
typedef unsigned v2u __attribute__((ext_vector_type(2)));
typedef float f32x4 __attribute__((ext_vector_type(4)));
#define LDS_WAIT() asm volatile("s_waitcnt lgkmcnt(0)" ::: "memory")
__device__ __forceinline__ unsigned f2bf(float f) { unsigned u = __builtin_bit_cast(unsigned, f); return (u + 0x7fffu + ((u >> 16) & 1u)) >> 16; }
__device__ __forceinline__ unsigned pk2(float lo, float hi) { return f2bf(lo) | (f2bf(hi) << 16); }
__device__ __forceinline__ float bf2f(unsigned short b) { return __builtin_bit_cast(float, (unsigned)b << 16); }
__device__ __forceinline__ float bflo(unsigned w) { return __builtin_bit_cast(float, w << 16); }
__device__ __forceinline__ float bfhi(unsigned w) { return __builtin_bit_cast(float, w & 0xffff0000u); }
__device__ __forceinline__ float wave_sum(float v) {
#pragma unroll
    for (int o = 1; o < 64; o <<= 1) v += __shfl_xor(v, o);
    return v;
}

constexpr size_t MiB = 1u << 20;
constexpr size_t MD = (size_t)M * D;
constexpr size_t WS_CTL = 0;
constexpr size_t WS_MOD = 1 * MiB;
constexpr size_t WS_COS = 2 * MiB, WS_SIN = 3 * MiB;
constexpr size_t WS_GATES = 4 * MiB;
constexpr size_t WS_GTAB = 5 * MiB;
constexpr size_t WS_WQKV = 8 * MiB;
constexpr size_t WS_WO = WS_WQKV + (size_t)QKV_W * D * 2;
constexpr size_t WS_WIN = WS_WO + (size_t)D * D * 2;
constexpr size_t WS_WMO = WS_WIN + (size_t)ML_INP * D * 2;
constexpr size_t WS_W1 = WS_WMO + (size_t)D * D * 2;
constexpr size_t WS_W2 = WS_W1 + (size_t)2 * DFF * D * 2;
constexpr size_t WS_H = WS_W2 + (size_t)2 * DFF * D * 2;
constexpr size_t WS_BIG = WS_H + MD * 2;
constexpr size_t WS_AO = WS_BIG + (size_t)M * DFF * 2;
constexpr size_t WS_Z = WS_AO + MD * 2;
constexpr size_t WS_X1 = WS_Z + MD * 4;
constexpr size_t WS_X2 = WS_X1 + MD * 4;
constexpr size_t WS_HZ = WS_X2 + MD * 4;
constexpr size_t WS_S = WS_HZ + 2 * MD * 2;
constexpr size_t WS_END = WS_S + (size_t)BATCH * ML_H * 32 * 64 * 64 * 4;
constexpr int LDS_BYTES = 147456;

struct Args { const float* in[23]; float* out; unsigned char* ws; int ph_lo, ph_hi; };
enum { I_X = 0, I_C, I_POS, I_AWQKV, I_ABQKV, I_ASINK, I_AWO, I_ABO, I_MWIN, I_MBIN, I_MNW, I_MWO, I_MBO, I_MODW, I_MODB, I_W1, I_B1, I_W2, I_B2, I_LNMG, I_LNMB, I_LNFG, I_LNFB };

__device__ __forceinline__ void phase_mod(const Args& a, LAS unsigned char* lds) {
    LAS float* sc = (LAS float*)lds;
    LAS float* red = (LAS float*)(lds + 32768);
    const float* c = a.in[I_C]; const float* mod_w = a.in[I_MODW]; const float* mod_b = a.in[I_MODB];
    float* mod = (float*)(a.ws + WS_MOD);
    const int tid = threadIdx.x, G = gridDim.x;
    for (int i = tid; i < BATCH * D; i += NTHREADS) { const float v = c[i]; sc[i] = v / (1.f + __expf(-v)); }
    __syncthreads();
    const int jj = tid & 31, ks = tid >> 5;
    for (int item = blockIdx.x; item < 2 * (6 * D / 32); item += G) {
        const int l = item / (6 * D / 32), j0 = (item % (6 * D / 32)) * 32;
        const float* w = mod_w + (size_t)l * D * (6 * D) + j0 + jj;
        float a0 = 0.f, a1 = 0.f, a2 = 0.f, a3 = 0.f;
#pragma unroll 16
        for (int k = ks * 128; k < ks * 128 + 128; ++k) { const float wv = w[(size_t)k * (6 * D)]; a0 += sc[k] * wv; a1 += sc[D + k] * wv; a2 += sc[2 * D + k] * wv; a3 += sc[3 * D + k] * wv; }
        red[(ks * 4 + 0) * 32 + jj] = a0; red[(ks * 4 + 1) * 32 + jj] = a1; red[(ks * 4 + 2) * 32 + jj] = a2; red[(ks * 4 + 3) * 32 + jj] = a3;
        __syncthreads();
        if (tid < 128) { const int b = tid >> 5; float s = 0.f;
#pragma unroll
            for (int q = 0; q < 16; ++q) s += red[(q * 4 + b) * 32 + jj];
            mod[((size_t)l * BATCH + b) * (6 * D) + j0 + jj] = s + mod_b[(size_t)l * 6 * D + j0 + jj]; }
        __syncthreads();
    }
    const int* pos = (const int*)a.in[I_POS]; float* cosT = (float*)(a.ws + WS_COS); float* sinT = (float*)(a.ws + WS_SIN);
    for (int i = blockIdx.x * NTHREADS + tid; i < M * 32; i += G * NTHREADS) {
        const int p = i & 31, row = i >> 5;
        const float inv_freq = 1.0f / powf(10000.0f, (float)(2 * p) / 64.0f);
        const float ang = (float)pos[row] * inv_freq;
        cosT[i] = cosf(ang); sinT[i] = sinf(ang);
    }
}

__device__ __forceinline__ void transpose_item(const float* W, int K, int pitch, int nblk, bf16* WT, LAS float* scr, int item, int lane) {
    const int kb = item / nblk, nb = item % nblk, k0 = 64 * kb, n0 = 32 * nb;
#pragma unroll 8
    for (int i = 0; i < 32; ++i) { const int kk = 2 * i + (lane >> 5); scr[kk * 33 + (lane & 31)] = W[(size_t)(k0 + kk) * pitch + n0 + (lane & 31)]; }
    LDS_WAIT(); asm volatile("" ::: "memory");
    const int c = lane & 7;
#pragma unroll
    for (int j = 0; j < 4; ++j) { const int n = (lane >> 3) + 8 * j; const LAS float* s = scr + (8 * c) * 33 + n;
        v4u o; o.x = pk2(s[0 * 33], s[1 * 33]); o.y = pk2(s[2 * 33], s[3 * 33]); o.z = pk2(s[4 * 33], s[5 * 33]); o.w = pk2(s[6 * 33], s[7 * 33]);
        *(v4u*)(WT + (size_t)(n0 + n) * K + k0 + 8 * c) = o; }
    LDS_WAIT(); asm volatile("" ::: "memory");
}
__device__ __forceinline__ void phase_prep(const Args& a, LAS unsigned char* lds) {
    const int tid = threadIdx.x, lane = tid & 63, wave = __builtin_amdgcn_readfirstlane(tid >> 6), G = gridDim.x;
    LAS float* scr = (LAS float*)(lds + wave * 16384);
    const int gw = blockIdx.x * NWAVES + wave, NGW = G * NWAVES;
    constexpr int I0 = (D / 64) * (QKV_W / 32), I1 = (D / 64) * (D / 32), I2 = (D / 64) * (ML_INP / 32), I3 = I1, I4 = (D / 64) * (DFF / 32), I6 = (DFF / 64) * (D / 32);
    constexpr int NITEMS = I0 + I1 + I2 + I3 + 2 * I4 + 2 * I6;
    for (int it = gw; it < NITEMS; it += NGW) {
        int r = it;
        if (r < I0) { transpose_item(a.in[I_AWQKV], D, QKV_W, QKV_W / 32, (bf16*)(a.ws + WS_WQKV), scr, r, lane); continue; } r -= I0;
        if (r < I1) { transpose_item(a.in[I_AWO], D, D, D / 32, (bf16*)(a.ws + WS_WO), scr, r, lane); continue; } r -= I1;
        if (r < I2) { transpose_item(a.in[I_MWIN], D, ML_IN, ML_INP / 32, (bf16*)(a.ws + WS_WIN), scr, r, lane); continue; } r -= I2;
        if (r < I3) { transpose_item(a.in[I_MWO], D, D, D / 32, (bf16*)(a.ws + WS_WMO), scr, r, lane); continue; } r -= I3;
        if (r < 2 * I4) { const int l = r / I4; transpose_item(a.in[I_W1] + (size_t)l * D * DFF, D, DFF, DFF / 32, (bf16*)(a.ws + WS_W1) + (size_t)l * DFF * D, scr, r % I4, lane); continue; } r -= 2 * I4;
        { const int l = r / I6; transpose_item(a.in[I_W2] + (size_t)l * DFF * D, DFF, D, D / 32, (bf16*)(a.ws + WS_W2) + (size_t)l * D * DFF, scr, r % I6, lane); }
    }
    const float* x = a.in[I_X]; const float* mod = (const float*)(a.ws + WS_MOD); bf16* h = (bf16*)(a.ws + WS_H);
    for (size_t i = (size_t)blockIdx.x * NTHREADS + tid; i < MD / 4; i += (size_t)G * NTHREADS) {
        const int row = (int)(i / (D / 4)), c4 = (int)(i % (D / 4)) * 4, b = row / SEQ;
        const f32x4 xv = *(const f32x4*)(x + i * 4), sh = *(const f32x4*)(mod + (size_t)b * 6 * D + c4), sc = *(const f32x4*)(mod + (size_t)b * 6 * D + D + c4);
        const f32x4 hv = xv * (sc + 1.0f) + sh;
        v2u o; o.x = pk2(hv[0], hv[1]); o.y = pk2(hv[2], hv[3]);
        *(v2u*)(h + i * 4) = o;
    }
}

template <bool HAS_H, bool GATES>
__device__ __forceinline__ void phase_ln(const Args& a, LAS unsigned char* lds, const float* z, const float* g, const float* bta, float* xo, const float* modl, int sh_off, int sc_off) {
    const int tid = threadIdx.x, lane = tid & 63, wave = __builtin_amdgcn_readfirstlane(tid >> 6), G = gridDim.x;
    bf16* h = (bf16*)(a.ws + WS_H);
    LAS float* wgt = (LAS float*)lds;
    if (GATES) {
        const float* w_in = a.in[I_MWIN];
        for (int i = tid; i < 16 * D; i += NTHREADS) { const int k = i >> 4, gi = i & 15; wgt[gi * D + k] = w_in[(size_t)k * ML_IN + ML_INP + gi]; }
        __syncthreads();
    }
    const int gw = blockIdx.x * NWAVES + wave, NGW = G * NWAVES;
    for (int row = gw; row < M; row += NGW) {
        const int b = row / SEQ;
        const f32x4* zr = (const f32x4*)(z + (size_t)row * D) + lane;
        f32x4 v[8]; float s = 0.f;
#pragma unroll
        for (int j = 0; j < 8; ++j) { v[j] = zr[64 * j]; s += (v[j][0] + v[j][1]) + (v[j][2] + v[j][3]); }
        const float mean = wave_sum(s) * (1.f / D); float s2 = 0.f;
#pragma unroll
        for (int j = 0; j < 8; ++j) { v[j] = v[j] - mean; s2 += (v[j][0] * v[j][0] + v[j][1] * v[j][1]) + (v[j][2] * v[j][2] + v[j][3] * v[j][3]); }
        const float rstd = 1.0f / sqrtf(wave_sum(s2) * (1.f / D) + LN_EPS);
#pragma unroll
        for (int j = 0; j < 8; ++j) { const int col = 4 * (64 * j + lane);
            v[j] = v[j] * rstd * *(const f32x4*)(g + col) + *(const f32x4*)(bta + col);
            *(f32x4*)(xo + (size_t)row * D + col) = v[j];
            if (HAS_H) { const float* mr = modl + (size_t)b * 6 * D;
                v[j] = v[j] * (*(const f32x4*)(mr + sc_off + col) + 1.0f) + *(const f32x4*)(mr + sh_off + col);
                v2u o; o.x = pk2(v[j][0], v[j][1]); o.y = pk2(v[j][2], v[j][3]);
                *(v2u*)(h + (size_t)row * D + col) = o; } }
        if (GATES) {
            float* gates = (float*)(a.ws + WS_GATES); const float* b_in = a.in[I_MBIN];
            float mine = 0.f;
#pragma unroll 1
            for (int gi = 0; gi < 16; ++gi) { float acc = 0.f;
#pragma unroll
                for (int j = 0; j < 8; ++j) { const f32x4 w = *(const LAS f32x4*)(wgt + gi * D + 4 * (64 * j + lane)); acc += (v[j][0] * w[0] + v[j][1] * w[1]) + (v[j][2] * w[2] + v[j][3] * w[3]); }
                acc = wave_sum(acc); if (lane == gi) mine = acc; }
            if (lane < 16) gates[(size_t)row * 16 + lane] = mine + b_in[ML_INP + lane];
        }
    }
    if (GATES) __syncthreads();
}

__device__ __forceinline__ void phase_headnorm(const Args& a) {
    const int tid = threadIdx.x, lane = tid & 63, wave = __builtin_amdgcn_readfirstlane(tid >> 6), G = gridDim.x;
    const bf16* hz = (const bf16*)(a.ws + WS_HZ); const bf16* proj = (const bf16*)(a.ws + WS_BIG); bf16* ym = (bf16*)(a.ws + WS_AO); const float* nw = a.in[I_MNW];
    const int gw = blockIdx.x * NWAVES + wave, NGW = G * NWAVES;
    for (int it = gw; it < M * ML_H; it += NGW) {
        const int row = it >> 2, hh = it & 3; const size_t off = (size_t)row * D + hh * ML_DV + lane * 8;
        const v4u f = *(const v4u*)(hz + off), bw = *(const v4u*)(hz + MD + off), ov = *(const v4u*)(proj + (size_t)row * ML_INP + 4096 + hh * ML_DV + lane * 8);
        float v[8]; float s = 0.f;
#pragma unroll
        for (int e = 0; e < 4; ++e) { v[2 * e] = bflo(f[e]) + bflo(bw[e]); v[2 * e + 1] = bfhi(f[e]) + bfhi(bw[e]); s += v[2 * e] + v[2 * e + 1]; }
        const float mean = wave_sum(s) * (1.f / ML_DV); float s2 = 0.f;
#pragma unroll
        for (int e = 0; e < 8; ++e) { v[e] -= mean; s2 += v[e] * v[e]; }
        const float rstd = 1.0f / sqrtf(wave_sum(s2) * (1.f / ML_DV) + HN_EPS);
        const f32x4 w0 = *(const f32x4*)(nw + hh * ML_DV + lane * 8), w1 = *(const f32x4*)(nw + hh * ML_DV + lane * 8 + 4);
        float y[8];
#pragma unroll
        for (int e = 0; e < 8; ++e) { const float og = (e & 1) ? bfhi(ov[e >> 1]) : bflo(ov[e >> 1]); const float wv = e < 4 ? w0[e] : w1[e - 4];
            y[e] = (1.f / (1.f + __expf(-og))) * (v[e] * rstd * wv); }
        v4u o; o.x = pk2(y[0], y[1]); o.y = pk2(y[2], y[3]); o.z = pk2(y[4], y[5]); o.w = pk2(y[6], y[7]);
        *(v4u*)(ym + off) = o;
    }
}

typedef short bf16x8_t __attribute__((ext_vector_type(8)));
typedef short s16x4_t __attribute__((ext_vector_type(4)));
typedef float f32x16 __attribute__((ext_vector_type(16)));
constexpr int AT_KCS = 6160, AT_VDS = 24640, AT_K = 0, AT_V = 8 * AT_KCS, AT_WS = AT_V + 2 * AT_VDS;
static_assert(AT_WS + NWAVES * 64 * 4 <= LDS_BYTES, "attention LDS");
__device__ __forceinline__ int crow(int r, int hi) { return (r & 3) + 8 * (r >> 2) + 4 * hi; }
__device__ __forceinline__ s16x4_t lds_tr16(const LAS unsigned char* p) { return __builtin_bit_cast(s16x4_t, __builtin_amdgcn_ds_read_tr16_b64_v4i16((LAS s16x4_t*)p)); }
__device__ __forceinline__ unsigned cvtpk(float lo, float hi) { unsigned r; asm volatile("v_cvt_pk_bf16_f32 %0, %1, %2" : "=v"(r) : "v"(lo), "v"(hi)); return r; }

__device__ __forceinline__ void phase_attn(const Args& a, LAS unsigned char* lds) {
    const int tid = threadIdx.x, lane = tid & 63, r32 = lane & 31, hi = lane >> 5, wid = __builtin_amdgcn_readfirstlane(tid >> 6), G = gridDim.x;
    const bf16* qkv = (const bf16*)(a.ws + WS_BIG); bf16* O = (bf16*)(a.ws + WS_AO); const float* sink = a.in[I_ASINK];
    LAS float* wsf = (LAS float*)(lds + AT_WS) + wid * 64;
    const LAS unsigned char* kfrag0 = lds + AT_K + hi * AT_KCS + r32 * 16;
    const LAS unsigned char* vfrag0 = lds + AT_V + ((lane >> 4) & 1) * 32 + (lane & 3) * 8 + (4 * hi + ((lane & 15) >> 2)) * 64;
    for (int u = blockIdx.x; u < BATCH * NKVH * (SEQ / 128); u += G) {
        const int kvh = u & 7, nb = (u >> 3) & 15, b = u >> 7, blk = nb * 128;
        __syncthreads();
#pragma unroll
        for (int i = 0; i < 6; ++i) {
            const int p = i * NTHREADS + tid, key = p >> 3, c = p & 7, kpos = blk - 128 + key;
            v4u kv = (v4u){0u, 0u, 0u, 0u}, vv = (v4u){0u, 0u, 0u, 0u};
            if ((unsigned)kpos < (unsigned)SEQ) { const bf16* src = qkv + ((size_t)b * SEQ + kpos) * QKV_W + 2048 + kvh * 64 + c * 8; kv = *(const v4u*)src; vv = *(const v4u*)(src + 512); }
            *(LAS v4u*)(lds + AT_K + c * AT_KCS + key * 16) = kv;
            *(LAS v4u*)(lds + AT_V + (c >> 2) * AT_VDS + key * 64 + (c & 3) * 16) = vv;
        }
        __syncthreads();
        const int hq = kvh * 4 + (wid >> 1);
        const float sink2 = sink[hq] * LOG2E;
        for (int sbi = 0; sbi < 2; ++sbi) {
            const int sb = 2 * (wid & 1) + sbi, qo = 32 * sb, tlo = sb >> 1;
            const bf16* qrow = qkv + ((size_t)b * SEQ + blk + qo + r32) * QKV_W + hq * 64 + hi * 8;
            bf16x8_t qr[4];
#pragma unroll
            for (int d0 = 0; d0 < 4; ++d0) qr[d0] = *(const bf16x8_t*)(qrow + d0 * 16);
            float m = sink2, l = hi ? 0.f : 1.f;
            f32x16 o0 = {}, o1 = {};
            for (int kt = tlo; kt < tlo + 5; ++kt) {
                f32x16 p0 = {}, p1 = {};
                const LAS unsigned char* kb = kfrag0 + kt * 1024;
#pragma unroll
                for (int d0 = 0; d0 < 4; ++d0) {
                    const bf16x8_t k0 = *(const LAS bf16x8_t*)(kb + d0 * 2 * AT_KCS), k1 = *(const LAS bf16x8_t*)(kb + d0 * 2 * AT_KCS + 512);
                    p0 = __builtin_amdgcn_mfma_f32_32x32x16_bf16(k0, qr[d0], p0, 0, 0, 0);
                    p1 = __builtin_amdgcn_mfma_f32_32x32x16_bf16(k1, qr[d0], p1, 0, 0, 0);
                }
                const int dbase = 64 * kt - 128 - qo - r32 + 4 * hi, pbase = blk - 128 + 64 * kt + 4 * hi;
                float rm = -1e30f;
#pragma unroll
                for (int r = 0; r < 16; ++r) {
                    const int cr = (r & 3) + 8 * (r >> 2), d0_ = dbase + cr, d1_ = d0_ + 32, kp0 = pbase + cr, kp1 = kp0 + 32;
                    const bool v0 = (d0_ <= 128) && (d0_ >= -128) && ((unsigned)kp0 < (unsigned)SEQ), v1 = (d1_ <= 128) && (d1_ >= -128) && ((unsigned)kp1 < (unsigned)SEQ);
                    p0[r] = v0 ? p0[r] : -1e30f; p1[r] = v1 ? p1[r] : -1e30f;
                    rm = fmaxf(rm, fmaxf(p0[r], p1[r]));
                }
                rm = fmaxf(rm, __shfl_xor(rm, 32));
                const float mn = fmaxf(m, rm), f = __builtin_amdgcn_exp2f(m - mn);
                m = mn;
                float ps = 0.f;
#pragma unroll
                for (int r = 0; r < 16; ++r) { p0[r] = __builtin_amdgcn_exp2f(p0[r] - mn); p1[r] = __builtin_amdgcn_exp2f(p1[r] - mn); ps += p0[r] + p1[r]; }
                l = l * f + ps;
                if (hi == 0) wsf[r32] = f;
                LDS_WAIT(); asm volatile("" ::: "memory");
#pragma unroll
                for (int r = 0; r < 16; ++r) { const float fr_ = wsf[crow(r, hi)]; o0[r] *= fr_; o1[r] *= fr_; }
                asm volatile("" ::: "memory");
                v4u pw[4];
#pragma unroll
                for (int s = 0; s < 2; ++s) {
                    pw[s] = (v4u){cvtpk(p0[8 * s], p0[8 * s + 1]), cvtpk(p0[8 * s + 2], p0[8 * s + 3]), cvtpk(p0[8 * s + 4], p0[8 * s + 5]), cvtpk(p0[8 * s + 6], p0[8 * s + 7])};
                    pw[2 + s] = (v4u){cvtpk(p1[8 * s], p1[8 * s + 1]), cvtpk(p1[8 * s + 2], p1[8 * s + 3]), cvtpk(p1[8 * s + 4], p1[8 * s + 5]), cvtpk(p1[8 * s + 6], p1[8 * s + 7])};
                }
                const LAS unsigned char* vb = vfrag0 + kt * 4096;
#pragma unroll
                for (int ks = 0; ks < 4; ++ks) {
                    const s16x4_t a0 = lds_tr16(vb + ks * 1024), a1 = lds_tr16(vb + ks * 1024 + 512), c0 = lds_tr16(vb + AT_VDS + ks * 1024), c1 = lds_tr16(vb + AT_VDS + ks * 1024 + 512);
                    const bf16x8_t vf0 = (bf16x8_t){a0[0], a0[1], a0[2], a0[3], a1[0], a1[1], a1[2], a1[3]}, vf1 = (bf16x8_t){c0[0], c0[1], c0[2], c0[3], c1[0], c1[1], c1[2], c1[3]};
                    const bf16x8_t pa = __builtin_bit_cast(bf16x8_t, pw[ks]);
                    o0 = __builtin_amdgcn_mfma_f32_32x32x16_bf16(pa, vf0, o0, 0, 0, 0);
                    o1 = __builtin_amdgcn_mfma_f32_32x32x16_bf16(pa, vf1, o1, 0, 0, 0);
                }
            }
            l += __shfl_xor(l, 32);
            if (hi == 0) wsf[32 + r32] = l;
            LDS_WAIT(); asm volatile("" ::: "memory");
            bf16* orow = O + ((size_t)b * SEQ + blk + qo) * D + hq * 64 + r32;
#pragma unroll
            for (int r = 0; r < 16; ++r) { const float il = 1.0f / wsf[32 + crow(r, hi)]; const int q = crow(r, hi);
                orow[(size_t)q * D] = (bf16)f2bf(o0[r] * il); orow[(size_t)q * D + 32] = (bf16)f2bf(o1[r] * il); }
            asm volatile("" ::: "memory");
        }
    }
}

typedef float f32x4_t __attribute__((ext_vector_type(4)));
constexpr int NSEQ = 2 * BATCH * ML_H;
constexpr size_t GT_B = 0, GT_M = (size_t)NSEQ * SEQ * 4, GT_T = 2 * GT_M, GT_C = 3 * GT_M;
static_assert(GT_C + NSEQ * 32 * 2 * 4 <= 3 * MiB, "gate tables");

__device__ __forceinline__ void phase_mlstm_pre(const Args& a) {
    const int tid = threadIdx.x, lane = tid & 63, wave = __builtin_amdgcn_readfirstlane(tid >> 6), G = gridDim.x;
    const float* gates = (const float*)(a.ws + WS_GATES);
    unsigned char* gt = a.ws + WS_GTAB;
    const int gw = blockIdx.x * NWAVES + wave;
    if (gw < NSEQ) {
        const int seq = gw, h = seq & 3, b = (seq >> 2) & 3, dir = seq >> 4;
        float* TB = (float*)(gt + GT_B) + (size_t)seq * SEQ; float* TM = (float*)(gt + GT_M) + (size_t)seq * SEQ; float* TT = (float*)(gt + GT_T) + (size_t)seq * SEQ; float* TC = (float*)(gt + GT_C) + (size_t)seq * 64;
        float mc = -1e30f;
        for (int cc = 0; cc < 32; ++cc) {
            const int c = dir ? 31 - cc : cc, t = c * 64 + (dir ? 63 - lane : lane);
            const float* gr = gates + ((size_t)b * SEQ + t) * 16;
            const float li = gr[(dir ? 8 : 0) + h], fp = gr[(dir ? 12 : 4) + h];
            float g = fminf(fp, 0.f) - log1pf(expf(-fabsf(fp)));
#pragma unroll
            for (int o = 1; o < 64; o <<= 1) { const float v = __shfl_up(g, o); if (lane >= o) g += v; }
            const float bb = li - g; float pm = bb;
#pragma unroll
            for (int o = 1; o < 64; o <<= 1) { const float v = __shfl_up(pm, o); if (lane >= o) pm = fmaxf(pm, v); }
            const float Mx = fmaxf(mc, pm);
            TB[t] = bb; TM[t] = Mx; TT[t] = g + Mx;
            const float Gs = __shfl(g, 63), Ml = __shfl(Mx, 63);
            if (lane == 0) { TC[c * 2] = mc; TC[c * 2 + 1] = Ml; }
            mc = Gs + Ml;
        }
    }
    const bf16* proj = (const bf16*)(a.ws + WS_BIG); float* Sg = (float*)(a.ws + WS_S);
    const int c16 = lane & 15, q4 = lane >> 4, tt = wave >> 1, st0 = 2 * (wave & 1);
    for (int it = blockIdx.x; it < BATCH * ML_H * 32; it += G) {
        const int c = it & 31, h = (it >> 5) & 3, b = it >> 7;
        const bf16* qp = proj + ((size_t)b * SEQ + c * 64 + tt * 16 + c16) * ML_INP + h * ML_DK + q4 * 8;
        const bf16* kp0 = proj + ((size_t)b * SEQ + c * 64 + st0 * 16 + c16) * ML_INP + 1024 + h * ML_DK + q4 * 8;
        const bf16* kp1 = kp0 + (size_t)16 * ML_INP;
        f32x4_t acc0 = {}, acc1 = {};
#pragma unroll
        for (int ks = 0; ks < 8; ++ks) {
            const bf16x8_t af = *(const bf16x8_t*)(qp + ks * 32), b0 = *(const bf16x8_t*)(kp0 + ks * 32), b1 = *(const bf16x8_t*)(kp1 + ks * 32);
            acc0 = __builtin_amdgcn_mfma_f32_16x16x32_bf16(af, b0, acc0, 0, 0, 0);
            acc1 = __builtin_amdgcn_mfma_f32_16x16x32_bf16(af, b1, acc1, 0, 0, 0);
        }
        float* sp = Sg + (size_t)it * 4096 + (size_t)(tt * 16 + 4 * q4) * 64 + st0 * 16 + c16;
#pragma unroll
        for (int r = 0; r < 4; ++r) { sp[r * 64] = acc0[r]; sp[r * 64 + 16] = acc1[r]; }
    }
}

constexpr int ML_QST = 528, ML_VST = 176, ML_SST = 144;
constexpr int ML_QS = 0, ML_KS = ML_QS + 64 * ML_QST, ML_VS = ML_KS + 64 * ML_QST, ML_VW = ML_VS + 64 * ML_VST, ML_SC = ML_VW + 64 * ML_VST, ML_CT = ML_SC + 64 * ML_SST, ML_SCAL = ML_CT + 80 * ML_QST;
static_assert(ML_SCAL + 4 * 64 * 4 <= LDS_BYTES, "mLSTM LDS");
__device__ __forceinline__ void phase_mlstm_scan(const Args& a, LAS unsigned char* lds) {
    const int tid = threadIdx.x, lane = tid & 63, wave = __builtin_amdgcn_readfirstlane(tid >> 6), G = gridDim.x;
    const int c16 = lane & 15, q4 = lane >> 4;
    const bf16* proj = (const bf16*)(a.ws + WS_BIG); const float* Sg = (const float*)(a.ws + WS_S); bf16* hz = (bf16*)(a.ws + WS_HZ);
    const unsigned char* gt = a.ws + WS_GTAB;
    LAS float* s_ea = (LAS float*)(lds + ML_SCAL); LAS float* s_emt = s_ea + 64;
    for (int item = blockIdx.x; item < NSEQ * 8; item += G) {
        const int sl = item & 7, seq = item >> 3, h = seq & 3, b = (seq >> 2) & 3, dir = seq >> 4;
        const float* TB = (const float*)(gt + GT_B) + (size_t)seq * SEQ; const float* TM = (const float*)(gt + GT_M) + (size_t)seq * SEQ; const float* TT = (const float*)(gt + GT_T) + (size_t)seq * SEQ; const float* TC = (const float*)(gt + GT_C) + (size_t)seq * 64;
        __syncthreads();
        for (int i = tid; i < 80 * ML_QST / 16; i += NTHREADS) *(LAS v4u*)(lds + ML_CT + i * 16) = (v4u){0u, 0u, 0u, 0u};
        f32x4_t cacc[2][5];
#pragma unroll
        for (int i = 0; i < 2; ++i)
#pragma unroll
            for (int j = 0; j < 5; ++j) cacc[i][j] = (f32x4_t){0.f, 0.f, 0.f, 0.f};
        for (int cc = 0; cc < 32; ++cc) {
            const int c = dir ? 31 - cc : cc; const size_t row0 = (size_t)b * SEQ + c * 64;
            const float mc = TC[c * 2], Mlast = TC[c * 2 + 1];
#pragma unroll
            for (int i = 0; i < 4; ++i) { const int p = i * NTHREADS + tid, r = p >> 5, ch = p & 31;
                const bf16* src = proj + (row0 + r) * ML_INP + h * ML_DK + ch * 8;
                *(LAS v4u*)(lds + ML_QS + r * ML_QST + ch * 16) = *(const v4u*)src;
                *(LAS v4u*)(lds + ML_KS + r * ML_QST + ch * 16) = *(const v4u*)(src + 1024); }
            { const int r = tid >> 3, ch = tid & 7;
              const v4u vv = *(const v4u*)(proj + (row0 + r) * ML_INP + 2048 + h * ML_DV + sl * 64 + ch * 8);
              const float w = expf(TB[c * 64 + r] - Mlast);
              *(LAS v4u*)(lds + ML_VS + r * ML_VST + ch * 16) = vv;
              v4u ws_; ws_.x = pk2(bflo(vv.x) * w, bfhi(vv.x) * w); ws_.y = pk2(bflo(vv.y) * w, bfhi(vv.y) * w); ws_.z = pk2(bflo(vv.z) * w, bfhi(vv.z) * w); ws_.w = pk2(bflo(vv.w) * w, bfhi(vv.w) * w);
              *(LAS v4u*)(lds + ML_VW + r * ML_VST + ch * 16) = ws_;
              if (ch == 0) { *(LAS v4u*)(lds + ML_VS + r * ML_VST + 128) = (v4u){0x3f80u, 0u, 0u, 0u}; *(LAS v4u*)(lds + ML_VS + r * ML_VST + 144) = (v4u){0u, 0u, 0u, 0u};
                             *(LAS v4u*)(lds + ML_VW + r * ML_VST + 128) = (v4u){f2bf(w), 0u, 0u, 0u}; *(LAS v4u*)(lds + ML_VW + r * ML_VST + 144) = (v4u){0u, 0u, 0u, 0u}; } }
            { const int t = tid >> 3, s0 = (tid & 7) * 8;
              const float* sp = Sg + ((size_t)((b * ML_H + h) * 32 + c)) * 4096 + t * 64 + s0;
              const f32x4_t sa = *(const f32x4_t*)sp, sb = *(const f32x4_t*)(sp + 4), ba = *(const f32x4_t*)(TB + c * 64 + s0), bb = *(const f32x4_t*)(TB + c * 64 + s0 + 4);
              const float Mt = TM[c * 64 + t]; float e[8];
#pragma unroll
              for (int j = 0; j < 8; ++j) { const int s = s0 + j; const bool ok = dir ? (s >= t) : (s <= t); const float sv = j < 4 ? sa[j] : sb[j - 4], bv = j < 4 ? ba[j] : bb[j - 4];
                  e[j] = ok ? sv * __expf(bv - Mt) : 0.f; }
              v4u o; o.x = pk2(e[0], e[1]); o.y = pk2(e[2], e[3]); o.z = pk2(e[4], e[5]); o.w = pk2(e[6], e[7]);
              *(LAS v4u*)(lds + ML_SC + t * ML_SST + s0 * 2) = o; }
            if (tid < 64) { s_ea[tid] = expf(mc - TM[c * 64 + tid]); s_emt[tid] = expf(-TT[c * 64 + tid]); }
            const float decay = expf(mc - Mlast);
            __syncthreads();
            {
                const int tt = wave >> 1, j0 = 2 * (wave & 1);
                f32x4_t ai[3], aa[3];
#pragma unroll
                for (int j = 0; j < 3; ++j) { ai[j] = (f32x4_t){0.f, 0.f, 0.f, 0.f}; aa[j] = (f32x4_t){0.f, 0.f, 0.f, 0.f}; }
                const LAS unsigned char* qa = lds + ML_QS + (tt * 16 + c16) * ML_QST + q4 * 16;
                const LAS unsigned char* cb0 = lds + ML_CT + (j0 * 16 + c16) * ML_QST + q4 * 16;
                const LAS unsigned char* cb2 = lds + ML_CT + (64 + c16) * ML_QST + q4 * 16;
#pragma unroll
                for (int ks = 0; ks < 8; ++ks) {
                    const bf16x8_t af = *(const LAS bf16x8_t*)(qa + ks * 64);
                    const bf16x8_t b0 = *(const LAS bf16x8_t*)(cb0 + ks * 64), b1 = *(const LAS bf16x8_t*)(cb0 + 16 * ML_QST + ks * 64), b2 = *(const LAS bf16x8_t*)(cb2 + ks * 64);
                    ai[0] = __builtin_amdgcn_mfma_f32_16x16x32_bf16(af, b0, ai[0], 0, 0, 0);
                    ai[1] = __builtin_amdgcn_mfma_f32_16x16x32_bf16(af, b1, ai[1], 0, 0, 0);
                    ai[2] = __builtin_amdgcn_mfma_f32_16x16x32_bf16(af, b2, ai[2], 0, 0, 0);
                }
                const LAS unsigned char* sa_ = lds + ML_SC + (tt * 16 + c16) * ML_SST + q4 * 16;
                const LAS unsigned char* vt = lds + ML_VS + (8 * q4 + (c16 >> 2)) * ML_VST + (c16 & 3) * 8;
#pragma unroll
                for (int ks = 0; ks < 2; ++ks) {
                    const bf16x8_t af = *(const LAS bf16x8_t*)(sa_ + ks * 64);
#pragma unroll
                    for (int j = 0; j < 3; ++j) { const int dvt = j < 2 ? j0 + j : 4;
                        const s16x4_t x0 = lds_tr16(vt + ks * 32 * ML_VST + dvt * 32), x1 = lds_tr16(vt + (ks * 32 + 4) * ML_VST + dvt * 32);
                        const bf16x8_t bf_ = (bf16x8_t){x0[0], x0[1], x0[2], x0[3], x1[0], x1[1], x1[2], x1[3]};
                        aa[j] = __builtin_amdgcn_mfma_f32_16x16x32_bf16(af, bf_, aa[j], 0, 0, 0); }
                }
                bf16* op = hz + (size_t)dir * MD + (row0 + tt * 16 + 4 * q4) * D + h * ML_DV + sl * 64 + j0 * 16 + c16;
#pragma unroll
                for (int r = 0; r < 4; ++r) { const int t = tt * 16 + 4 * q4 + r; const float ea = s_ea[t], emt = s_emt[t];
                    const float den = __shfl(ea * ai[2][r] + aa[2][r], lane & 48);
                    const float inv = 1.0f / fmaxf(fabsf(den), emt);
                    op[(size_t)r * D] = (bf16)f2bf((ea * ai[0][r] + aa[0][r]) * inv); op[(size_t)r * D + 16] = (bf16)f2bf((ea * ai[1][r] + aa[1][r]) * inv); }
            }
            {
#pragma unroll
                for (int i = 0; i < 2; ++i)
#pragma unroll
                    for (int j = 0; j < 5; ++j) cacc[i][j] = cacc[i][j] * decay;
                const LAS unsigned char* kt_ = lds + ML_KS + (8 * q4 + (c16 >> 2)) * ML_QST + (wave * 32 + (c16 & 3) * 4) * 2;
                const LAS unsigned char* vt = lds + ML_VW + (8 * q4 + (c16 >> 2)) * ML_VST + (c16 & 3) * 8;
#pragma unroll
                for (int ks = 0; ks < 2; ++ks) {
                    bf16x8_t af[2];
#pragma unroll
                    for (int i = 0; i < 2; ++i) { const s16x4_t x0 = lds_tr16(kt_ + ks * 32 * ML_QST + i * 32), x1 = lds_tr16(kt_ + (ks * 32 + 4) * ML_QST + i * 32);
                        af[i] = (bf16x8_t){x0[0], x0[1], x0[2], x0[3], x1[0], x1[1], x1[2], x1[3]}; }
#pragma unroll
                    for (int j = 0; j < 5; ++j) { const s16x4_t x0 = lds_tr16(vt + ks * 32 * ML_VST + j * 32), x1 = lds_tr16(vt + (ks * 32 + 4) * ML_VST + j * 32);
                        const bf16x8_t bf_ = (bf16x8_t){x0[0], x0[1], x0[2], x0[3], x1[0], x1[1], x1[2], x1[3]};
                        cacc[0][j] = __builtin_amdgcn_mfma_f32_16x16x32_bf16(af[0], bf_, cacc[0][j], 0, 0, 0);
                        cacc[1][j] = __builtin_amdgcn_mfma_f32_16x16x32_bf16(af[1], bf_, cacc[1][j], 0, 0, 0); }
                }
            }
            __syncthreads();
#pragma unroll
            for (int i = 0; i < 2; ++i)
#pragma unroll
                for (int j = 0; j < 5; ++j) { v2u o; o.x = pk2(cacc[i][j][0], cacc[i][j][1]); o.y = pk2(cacc[i][j][2], cacc[i][j][3]);
                    *(LAS v2u*)(lds + ML_CT + (j * 16 + c16) * ML_QST + (wave * 32 + i * 16 + 4 * q4) * 2) = o; }
        }
    }
}

namespace cg = cooperative_groups;
__global__ void __launch_bounds__(NTHREADS, 2) mega(Args a) {
    extern __shared__ __attribute__((aligned(16))) unsigned char lds_raw[];
    LAS unsigned char* lds = (LAS unsigned char*)lds_raw;
    cg::grid_group grid = cg::this_grid();
    const int lo = a.ph_lo, hi = a.ph_hi, G = gridDim.x;
#define IN(k) (lo <= (k) && (k) < hi)
#define SEAM(k) do { if (IN(k) && IN((k) + 1)) grid.sync(); } while (0)
    unsigned char* ws = a.ws;
    const float* mod0 = (const float*)(ws + WS_MOD); const float* mod1 = mod0 + (size_t)BATCH * 6 * D;
    bf16* Hb = (bf16*)(ws + WS_H); bf16* BIG = (bf16*)(ws + WS_BIG); bf16* AO = (bf16*)(ws + WS_AO);
    float* Z = (float*)(ws + WS_Z); float* X1 = (float*)(ws + WS_X1); float* X2 = (float*)(ws + WS_X2);

    if (IN(0)) { phase_mod(a, lds); } SEAM(0);
    if (IN(1)) { phase_prep(a, lds); } SEAM(1);
    if (IN(2)) {
        pg8::Gemm g{Hb, (const bf16*)(ws + WS_WQKV), M, QKV_W, D}; pg8::StaticOrder S; S.init(M, QKV_W, G, (int)blockIdx.x);
        pg8::EpiQKV E{BIG, QKV_W, a.in[I_ABQKV], (const float*)(ws + WS_COS), (const float*)(ws + WS_SIN), 8, 10, QSCALE};
        pg8::gemm_phase<pg8::EpiQKV, pg8::StaticOrder, true, true>(lds, g, S, E);
    } SEAM(2);
    if (IN(3)) { phase_attn(a, lds); } SEAM(3);
    if (IN(4)) {
        pg8::Gemm g{AO, (const bf16*)(ws + WS_WO), M, D, D}; pg8::StaticOrder S; S.init(M, D, G, (int)blockIdx.x);
        pg8::EpiRes E{Z, D, a.in[I_ABO], a.in[I_X], mod0 + 2 * D, 6 * D, SEQ / 256, ALPHA};
        pg8::gemm_phase<pg8::EpiRes, pg8::StaticOrder, true, true>(lds, g, S, E);
    } SEAM(4);
    if (IN(5)) { phase_ln<true, false>(a, lds, Z, a.in[I_LNMG], a.in[I_LNMB], X1, mod0, 3 * D, 4 * D); } SEAM(5);
    if (IN(6)) {
        pg8::Gemm g{Hb, (const bf16*)(ws + WS_W1), M, DFF, D}; pg8::StaticOrder S; S.init(M, DFF, G, (int)blockIdx.x);
        pg8::EpiBf16<1> E{BIG, DFF, a.in[I_B1], 0, 1.f};
        pg8::gemm_phase<pg8::EpiBf16<1>, pg8::StaticOrder, true, true>(lds, g, S, E);
    } SEAM(6);
    if (IN(7)) {
        pg8::Gemm g{BIG, (const bf16*)(ws + WS_W2), M, D, DFF}; pg8::StaticOrder S; S.init(M, D, G, (int)blockIdx.x);
        pg8::EpiRes E{Z, D, a.in[I_B2], X1, mod0 + 5 * D, 6 * D, SEQ / 256, ALPHA};
        pg8::gemm_phase<pg8::EpiRes, pg8::StaticOrder, true, true>(lds, g, S, E);
    } SEAM(7);
    if (IN(8)) { phase_ln<true, true>(a, lds, Z, a.in[I_LNFG], a.in[I_LNFB], X2, mod1, 0, D); } SEAM(8);
    if (IN(9)) {
        pg8::Gemm g{Hb, (const bf16*)(ws + WS_WIN), M, ML_INP, D}; pg8::StaticOrder S; S.init(M, ML_INP, G, (int)blockIdx.x);
        pg8::EpiBf16<0> E{BIG, ML_INP, a.in[I_MBIN], 4, 0.0625f};
        pg8::gemm_phase<pg8::EpiBf16<0>, pg8::StaticOrder, true, true>(lds, g, S, E);
    } SEAM(9);
    if (IN(10)) { phase_mlstm_pre(a); } SEAM(10);
    if (IN(11)) { phase_mlstm_scan(a, lds); } SEAM(11);
    if (IN(12)) { phase_headnorm(a); } SEAM(12);
    if (IN(13)) {
        pg8::Gemm g{AO, (const bf16*)(ws + WS_WMO), M, D, D}; pg8::StaticOrder S; S.init(M, D, G, (int)blockIdx.x);
        pg8::EpiRes E{Z, D, a.in[I_MBO], X2, mod1 + 2 * D, 6 * D, SEQ / 256, ALPHA};
        pg8::gemm_phase<pg8::EpiRes, pg8::StaticOrder, true, true>(lds, g, S, E);
    } SEAM(13);
    if (IN(14)) { phase_ln<true, false>(a, lds, Z, a.in[I_LNMG] + D, a.in[I_LNMB] + D, X1, mod1, 3 * D, 4 * D); } SEAM(14);
    if (IN(15)) {
        pg8::Gemm g{Hb, (const bf16*)(ws + WS_W1) + (size_t)DFF * D, M, DFF, D}; pg8::StaticOrder S; S.init(M, DFF, G, (int)blockIdx.x);
        pg8::EpiBf16<1> E{BIG, DFF, a.in[I_B1] + DFF, 0, 1.f};
        pg8::gemm_phase<pg8::EpiBf16<1>, pg8::StaticOrder, true, true>(lds, g, S, E);
    } SEAM(15);
    if (IN(16)) {
        pg8::Gemm g{BIG, (const bf16*)(ws + WS_W2) + (size_t)D * DFF, M, D, DFF}; pg8::StaticOrder S; S.init(M, D, G, (int)blockIdx.x);
        pg8::EpiRes E{Z, D, a.in[I_B2] + D, X1, mod1 + 5 * D, 6 * D, SEQ / 256, ALPHA};
        pg8::gemm_phase<pg8::EpiRes, pg8::StaticOrder, true, true>(lds, g, S, E);
    } SEAM(16);
    if (IN(17)) { phase_ln<false, false>(a, lds, Z, a.in[I_LNFG] + D, a.in[I_LNFB] + D, a.out, nullptr, 0, 0); }
#undef IN
#undef SEAM
}

extern "C" void kernel_launch(void* const* d_in, const int* in_sizes, int n_in, void* d_out, int out_size, void* d_ws, size_t ws_size, hipStream_t stream) {
    static int grid = 0;
    if (grid == 0) {
        if (n_in != 23 || ws_size < WS_END) { fprintf(stderr, "kernel_launch: need 23 inputs and %zu bytes of workspace; got %d, %zu\n", (size_t)WS_END, n_in, ws_size); grid = -1; return; }
        int dev = 0, cus = 0, per_cu = 0;
        hipGetDevice(&dev); hipDeviceGetAttribute(&cus, hipDeviceAttributeMultiprocessorCount, dev);
        if (hipFuncSetAttribute((const void*)mega, hipFuncAttributeMaxDynamicSharedMemorySize, LDS_BYTES) != hipSuccess) { fprintf(stderr, "kernel_launch: hipFuncSetAttribute failed\n"); grid = -1; return; }
        hipOccupancyMaxActiveBlocksPerMultiprocessor(&per_cu, (const void*)mega, NTHREADS, LDS_BYTES);
        (void)hipGetLastError();
        if (per_cu < 1) { fprintf(stderr, "kernel_launch: occupancy query says %d blocks per CU\n", per_cu); per_cu = 1; }
        grid = cus * per_cu;
    }
    if (grid < 0) return;
    Args a{};
    for (int i = 0; i < 23; ++i) a.in[i] = (const float*)d_in[i];
    a.out = (float*)d_out; a.ws = (unsigned char*)d_ws;
    a.ph_lo = 0; a.ph_hi = 18;
    void* kargs[] = {&a};
    const hipError_t e = hipLaunchCooperativeKernel((const void*)mega, dim3(grid), dim3(NTHREADS), kargs, LDS_BYTES, stream);
    if (e != hipSuccess) fprintf(stderr, "kernel_launch: cooperative launch failed: %s (grid %d)\n", hipGetErrorString(e), grid);
}
```

```cpp
#include <hip/hip_runtime.h>
#include <hip/hip_cooperative_groups.h>
#include <cstdio>
#include <cstdint>
#include <cmath>

constexpr int D = 2048, BATCH = 4, SEQ = 2048, M = BATCH * SEQ;
constexpr int QKV_W = 3072, NQH = 32, NKVH = 8;
constexpr int ML_H = 4, ML_DV = 512, ML_DK = 256, ML_IN = 6160, ML_INP = 6144;
constexpr int DFF = 8192;
constexpr float ALPHA = 1.4142135623730951f;
constexpr float LN_EPS = 1e-5f, HN_EPS = 1e-6f;
constexpr float LOG2E = 1.4426950408889634f;
constexpr float QSCALE = 0.125f * LOG2E;
constexpr int NWAVES = 8, NTHREADS = 512;

namespace pg8 {
#define PG8_LAS __attribute__((address_space(3)))
typedef unsigned short bf16_t;
typedef short bf16x8 __attribute__((ext_vector_type(8)));
typedef float f32x4 __attribute__((ext_vector_type(4)));
typedef unsigned u32x4 __attribute__((ext_vector_type(4)));
constexpr int BM = 256, BK = 64, HALF = 128, HTB = HALF * BK * 2  , STAGE_BYTES = 8 * HTB, NXCD = 8, WGM = 8;

__host__ __device__ __forceinline__ int lds_byte(int r, int c) { const int st = (r >> 4) * 2 + (c >> 5), rr = r & 15, cc = c & 31, ob = rr * 64 + cc * 2; return st * 1024 + (ob ^ (((ob >> 9) & 1) << 5)); }
__host__ __device__ __forceinline__ void stage_rc(int b, int& R, int& C) { const int st = b / 1024, sb = b % 1024, swz = sb ^ (((sb >> 9) & 1) << 5); R = (st >> 1) * 16 + swz / 64; C = (st & 1) * 32 + (swz % 64) / 2; }
__host__ __device__ __forceinline__ int perm32(int rho) { const int n = rho >> 4, i = rho & 15; return 8 * (i >> 2) + 4 * n + (i & 3); }

struct Unit { int pm, pn; };
struct Gemm { const bf16_t* A; const bf16_t* Bt; int M, N, K; };

struct StaticOrder {
    int nM, nN, nwg, G, c;
    __host__ __device__ void init(int M, int N, int G_, int c_) { nM = M / BM; nN = N / BM; nwg = nM * nN; G = G_; c = c_; }
    __host__ __device__ bool next(int i, Unit& u) const {
        const long L = (long)i * G + c; if (L >= nwg) return false;
        int wgid = (int)L; { const int q = nwg / NXCD, r = nwg % NXCD, xcd = wgid % NXCD, off = wgid / NXCD; wgid = (xcd < r ? xcd * (q + 1) : r * (q + 1) + (xcd - r) * q) + off; }
        const int nig = WGM * nN, gid = wgid / nig, fm = gid * WGM, gsz = (nM - fm) < WGM ? (nM - fm) : WGM;
        u.pm = fm + ((wgid % nig) % gsz); u.pn = (wgid % nig) / gsz; return true;
    }
    __device__ __forceinline__ void a_ready(const Unit&) const {}
    __device__ __forceinline__ void done(const Unit&) const {}
};

__device__ __forceinline__ unsigned cvt_pk_bf16(float lo, float hi) { unsigned r; asm volatile("v_cvt_pk_bf16_f32 %0, %1, %2" : "=v"(r) : "v"(lo), "v"(hi)); return r; }

template <int ACT> struct EpiBf16 {
    static constexpr int PERM = 1; static constexpr bool AFTER_DRAIN = false;
    bf16_t* O; int ldc; const float* bias; int npn0; float scale0;
    __device__ __forceinline__ void operator()(const f32x4 (&acc)[2][2][4][2], const Unit& u, int wr, int wc, int fr, int fq) const {
        const int row0 = u.pm * BM + wr * 64 + fr, col0 = u.pn * BM + wc * 32 + 8 * fq;
        const float sc = (u.pn < npn0) ? scale0 : 1.f;
        f32x4 bv[2][2];
#pragma unroll
        for (int bj = 0; bj < 2; ++bj)
#pragma unroll
            for (int n = 0; n < 2; ++n) bv[bj][n] = *(const f32x4*)(bias + col0 + bj * HALF + 4 * n);
#pragma unroll
        for (int ai = 0; ai < 2; ++ai)
#pragma unroll
            for (int m = 0; m < 4; ++m) { bf16_t* rowp = O + (size_t)(row0 + ai * HALF + m * 16) * ldc + col0;
#pragma unroll
                for (int bj = 0; bj < 2; ++bj) { f32x4 v0 = acc[ai][bj][m][0] + bv[bj][0], v1 = acc[ai][bj][m][1] + bv[bj][1];
                    if (ACT == 1) {
#pragma unroll
                        for (int e = 0; e < 4; ++e) { float a = v0[e] > 0.f ? v0[e] : 0.f, b = v1[e] > 0.f ? v1[e] : 0.f; v0[e] = a * a; v1[e] = b * b; } }
                    v0 = v0 * sc; v1 = v1 * sc; u32x4 w; w.x = cvt_pk_bf16(v0[0], v0[1]); w.y = cvt_pk_bf16(v0[2], v0[3]); w.z = cvt_pk_bf16(v1[0], v1[1]); w.w = cvt_pk_bf16(v1[2], v1[3]);
                    *(u32x4*)(rowp + bj * HALF) = w; } }
    }
};

struct EpiQKV {
    static constexpr int PERM = 2; static constexpr bool AFTER_DRAIN = false;
    bf16_t* O; int ldc; const float* bias; const float* cosT; const float* sinT; int npn_q, npn_rope; float qscale;
    __device__ __forceinline__ void operator()(const f32x4 (&acc)[2][2][4][2], const Unit& u, int wr, int wc, int fr, int fq) const {
        const int row0 = u.pm * BM + wr * 64 + fr, col0 = u.pn * BM + wc * 64 + 8 * fq;
        const float sc = (u.pn < npn_q) ? qscale : 1.f; const bool rope = u.pn < npn_rope;
        f32x4 bv[2][2];
#pragma unroll
        for (int bj = 0; bj < 2; ++bj)
#pragma unroll
            for (int n = 0; n < 2; ++n) bv[bj][n] = *(const f32x4*)(bias + col0 + bj * 32 + 4 * n);
#pragma unroll
        for (int ai = 0; ai < 2; ++ai)
#pragma unroll
            for (int m = 0; m < 4; ++m) { const int row = row0 + ai * HALF + m * 16; bf16_t* rowp = O + (size_t)row * ldc + col0;
                f32x4 lo0 = acc[ai][0][m][0] + bv[0][0], lo1 = acc[ai][0][m][1] + bv[0][1], hi0 = acc[ai][1][m][0] + bv[1][0], hi1 = acc[ai][1][m][1] + bv[1][1];
                if (rope) { const f32x4 c0 = *(const f32x4*)(cosT + (size_t)row * 32 + 8 * fq), c1 = *(const f32x4*)(cosT + (size_t)row * 32 + 8 * fq + 4);
                    const f32x4 s0 = *(const f32x4*)(sinT + (size_t)row * 32 + 8 * fq), s1 = *(const f32x4*)(sinT + (size_t)row * 32 + 8 * fq + 4);
                    const f32x4 a0 = lo0 * c0 - hi0 * s0, a1 = lo1 * c1 - hi1 * s1, b0 = hi0 * c0 + lo0 * s0, b1 = hi1 * c1 + lo1 * s1;
                    lo0 = a0; lo1 = a1; hi0 = b0; hi1 = b1; }
                lo0 = lo0 * sc; lo1 = lo1 * sc; hi0 = hi0 * sc; hi1 = hi1 * sc;
                u32x4 w; w.x = cvt_pk_bf16(lo0[0], lo0[1]); w.y = cvt_pk_bf16(lo0[2], lo0[3]); w.z = cvt_pk_bf16(lo1[0], lo1[1]); w.w = cvt_pk_bf16(lo1[2], lo1[3]);
                *(u32x4*)(rowp) = w;
                w.x = cvt_pk_bf16(hi0[0], hi0[1]); w.y = cvt_pk_bf16(hi0[2], hi0[3]); w.z = cvt_pk_bf16(hi1[0], hi1[1]); w.w = cvt_pk_bf16(hi1[2], hi1[3]);
                *(u32x4*)(rowp + 32) = w; }
    }
};

struct EpiRes {
    static constexpr int PERM = 1; static constexpr bool AFTER_DRAIN = false;
    float* Z; int ldc; const float* bias; const float* res; const float* gate; int gate_ld; int tiles_per_batch; float alpha;
    __device__ __forceinline__ void operator()(const f32x4 (&acc)[2][2][4][2], const Unit& u, int wr, int wc, int fr, int fq) const {
        const int row0 = u.pm * BM + wr * 64 + fr, col0 = u.pn * BM + wc * 32 + 8 * fq;
        const float* gp = gate + (size_t)(u.pm / tiles_per_batch) * gate_ld;
        f32x4 bv[2][2], gv[2][2];
#pragma unroll
        for (int bj = 0; bj < 2; ++bj)
#pragma unroll
            for (int n = 0; n < 2; ++n) { bv[bj][n] = *(const f32x4*)(bias + col0 + bj * HALF + 4 * n); gv[bj][n] = *(const f32x4*)(gp + col0 + bj * HALF + 4 * n) + 1.0f; }
#pragma unroll
        for (int ai = 0; ai < 2; ++ai)
#pragma unroll
            for (int m = 0; m < 4; ++m) { const size_t off = (size_t)(row0 + ai * HALF + m * 16) * ldc + col0;
#pragma unroll
                for (int bj = 0; bj < 2; ++bj)
#pragma unroll
                    for (int n = 0; n < 2; ++n) { const f32x4 r = *(const f32x4*)(res + off + bj * HALF + 4 * n);
                        *(f32x4*)(Z + off + bj * HALF + 4 * n) = r * alpha + gv[bj][n] * (acc[ai][bj][m][n] + bv[bj][n]); }
                asm volatile("" ::: "memory"); }
    }
};

template <class Epi, class Sched, bool ALIGN_EPI = false, bool SP2 = false>
__device__ __forceinline__ void gemm_phase(PG8_LAS unsigned char* lds, const Gemm g, const Sched& S, const Epi& E) {
    const int tid = threadIdx.x, wid = __builtin_amdgcn_readfirstlane(tid >> 6), lane = tid & 63, wr = wid >> 2, wc = wid & 3, fr = lane & 15, fq = lane >> 4;
    const int K = g.K, nt = K / BK;
    unsigned voffA[2], voffB[2];
#pragma unroll
    for (int i = 0; i < 2; ++i) { int R, C; stage_rc(tid * 16 + i * 8192, R, C); const int Rb = (Epi::PERM == 2) ? (64 * (R >> 5) + perm32(R & 31)) : (Epi::PERM == 1) ? ((R & ~31) + perm32(R & 31)) : R;
        voffA[i] = (unsigned)(R * K + C) * 2u; voffB[i] = (unsigned)(Rb * K + C) * 2u; }
    const size_t kstep = (size_t)(BK * 2);
    const size_t hstep = (size_t)HALF * K * 2;
    const size_t tstep = 2 * hstep;
    const size_t bhstep = (Epi::PERM == 2) ? (size_t)32 * K * 2 : hstep;
    const unsigned ldsw = (unsigned)wid * 1024u;
    const int aoff = lds_byte(wr * 64 + fr, fq * 8), boff = lds_byte(wc * 32 + fr, fq * 8);
#define PG8_SA(b, h) (((b) * 2 + (h)) * HTB)
#define PG8_SB(b, h) ((4 + (b) * 2 + (h)) * HTB)
#define PG8_STAGE(bufoff, gbase, voff) do { _Pragma("unroll") for (int _i = 0; _i < 2; ++_i) \
        __builtin_amdgcn_global_load_lds((const unsigned*)((const char*)(gbase) + (voff)[_i]), (PG8_LAS unsigned*)(lds + (bufoff) + ldsw + _i * 8192), 16, 0, 0); } while (0)
#define PG8_LDA(dst, b, h) do { _Pragma("unroll") for (int m = 0; m < 4; ++m) _Pragma("unroll") for (int k = 0; k < 2; ++k) dst[m][k] = *(const PG8_LAS bf16x8*)(lds + PG8_SA(b, h) + aoff + m * 2048 + k * 1024); } while (0)
#define PG8_LDB(dst, b, h) do { _Pragma("unroll") for (int n = 0; n < 2; ++n) _Pragma("unroll") for (int k = 0; k < 2; ++k) dst[n][k] = *(const PG8_LAS bf16x8*)(lds + PG8_SB(b, h) + boff + n * 2048 + k * 1024); } while (0)
#define PG8_MMA(ai, bj, At, Bt) do { __builtin_amdgcn_s_setprio(1); _Pragma("unroll") for (int m = 0; m < 4; ++m) _Pragma("unroll") for (int n = 0; n < 2; ++n) _Pragma("unroll") for (int k = 0; k < 2; ++k) \
        acc[ai][bj][m][n] = __builtin_amdgcn_mfma_f32_16x16x32_bf16(Bt[n][k], At[m][k], acc[ai][bj][m][n], 0, 0, 0); __builtin_amdgcn_s_setprio(0); } while (0)
#define PG8_WAIT_V(n) asm volatile("s_waitcnt vmcnt(" #n ")" ::: "memory")
#define PG8_WAIT_L(n) asm volatile("s_waitcnt lgkmcnt(" #n ")" ::: "memory")
#define PG8_BAR __builtin_amdgcn_s_barrier()
#define PG8_SCHED __builtin_amdgcn_sched_barrier(0)
    Unit cur, nxt; int ui = 0;
    if (!S.next(0, cur)) return;
    f32x4 acc[2][2][4][2];
#pragma unroll
    for (int a = 0; a < 2; ++a)
#pragma unroll
        for (int b = 0; b < 2; ++b)
#pragma unroll
            for (int m = 0; m < 4; ++m)
#pragma unroll
                for (int n = 0; n < 2; ++n) acc[a][b][m][n] = (f32x4){0.f, 0.f, 0.f, 0.f};
    bf16x8 At[4][2], B0[2][2], B1[2][2];
    const char* cA = (const char*)g.A + (size_t)cur.pm * tstep; const char* cB = (const char*)g.Bt + (size_t)cur.pn * tstep;
    S.a_ready(cur);
    if constexpr (SP2) {
        PG8_STAGE(PG8_SB(0, 0), cB, voffB); PG8_STAGE(PG8_SB(0, 1), cB + bhstep, voffB); PG8_STAGE(PG8_SA(0, 0), cA, voffA); PG8_STAGE(PG8_SA(0, 1), cA + hstep, voffA);
        if (wr == 1) PG8_BAR;
        PG8_WAIT_V(2); PG8_BAR;
        PG8_STAGE(PG8_SB(1, 0), cB + kstep, voffB); PG8_STAGE(PG8_SA(1, 0), cA + kstep, voffA); PG8_STAGE(PG8_SB(1, 1), cB + bhstep + kstep, voffB);
        PG8_WAIT_V(6); PG8_BAR;
    } else {
        PG8_STAGE(PG8_SB(0, 0), cB, voffB); PG8_STAGE(PG8_SA(0, 0), cA, voffA); PG8_STAGE(PG8_SB(0, 1), cB + bhstep, voffB); PG8_STAGE(PG8_SA(0, 1), cA + hstep, voffA);
        if (wr == 1) PG8_BAR;
        PG8_WAIT_V(4); PG8_BAR;
        PG8_STAGE(PG8_SB(1, 0), cB + kstep, voffB); PG8_STAGE(PG8_SA(1, 0), cA + kstep, voffA); PG8_STAGE(PG8_SB(1, 1), cB + bhstep + kstep, voffB);
        PG8_WAIT_V(6); PG8_BAR;
    }
    for (;;) {
        const bool has_next = S.next(ui + 1, nxt);
        const char* nA = has_next ? (const char*)g.A + (size_t)nxt.pm * tstep : cA; const char* nB = has_next ? (const char*)g.Bt + (size_t)nxt.pn * tstep : cB;
        for (int t = 0; t < nt; t += 2) {
            const bool last = (t == nt - 2);
            const char* a1 = cA + (size_t)(t + 1) * kstep;
            const char* a2 = last ? nA : cA + (size_t)(t + 2) * kstep; const char* b2 = last ? nB : cB + (size_t)(t + 2) * kstep;
            const char* a3 = a2 + kstep; const char* b3 = b2 + kstep;
            if (last && has_next) S.a_ready(nxt);
            if constexpr (SP2) {
            PG8_LDB(B0, 0, 0); PG8_LDB(B1, 0, 1); PG8_SCHED; PG8_LDA(At, 0, 0); PG8_STAGE(PG8_SA(1, 1), a1 + hstep, voffA);
            PG8_WAIT_V(8); PG8_WAIT_L(0); PG8_BAR; PG8_MMA(0, 0, At, B0); PG8_MMA(0, 1, At, B1); PG8_BAR; PG8_SCHED;
            PG8_LDA(At, 0, 1); PG8_STAGE(PG8_SB(0, 0), b2, voffB); PG8_STAGE(PG8_SB(0, 1), b2 + bhstep, voffB); PG8_STAGE(PG8_SA(0, 0), a2, voffA);
            PG8_WAIT_V(8); PG8_WAIT_L(0); PG8_BAR; PG8_MMA(1, 0, At, B0); PG8_MMA(1, 1, At, B1); PG8_BAR; PG8_SCHED;
            PG8_LDB(B0, 1, 0); PG8_LDB(B1, 1, 1); PG8_SCHED; PG8_LDA(At, 1, 0); PG8_STAGE(PG8_SA(0, 1), a2 + hstep, voffA);
            PG8_WAIT_V(8); PG8_WAIT_L(0); PG8_BAR; PG8_MMA(0, 0, At, B0); PG8_MMA(0, 1, At, B1); PG8_BAR; PG8_SCHED;
            PG8_LDA(At, 1, 1); PG8_STAGE(PG8_SB(1, 0), b3, voffB); PG8_STAGE(PG8_SB(1, 1), b3 + bhstep, voffB); PG8_STAGE(PG8_SA(1, 0), a3, voffA);
            PG8_WAIT_V(8); PG8_WAIT_L(0); PG8_BAR; PG8_MMA(1, 0, At, B0); PG8_MMA(1, 1, At, B1); PG8_BAR; PG8_SCHED;
            } else {
            PG8_LDB(B0, 0, 0); PG8_SCHED; PG8_LDA(At, 0, 0); PG8_STAGE(PG8_SA(1, 1), a1 + hstep, voffA);
            PG8_WAIT_L(8); PG8_BAR; PG8_WAIT_L(0); PG8_MMA(0, 0, At, B0); PG8_BAR; PG8_SCHED;
            PG8_LDB(B1, 0, 1); PG8_STAGE(PG8_SB(0, 0), b2, voffB);
            PG8_BAR; PG8_WAIT_L(0); PG8_MMA(0, 1, At, B1); PG8_BAR;
            PG8_LDA(At, 0, 1); PG8_STAGE(PG8_SA(0, 0), a2, voffA);
            PG8_BAR; PG8_WAIT_L(0); PG8_MMA(1, 0, At, B0); PG8_BAR; PG8_SCHED;
            PG8_STAGE(PG8_SB(0, 1), b2 + bhstep, voffB);
            PG8_WAIT_V(6); PG8_BAR; PG8_MMA(1, 1, At, B1); PG8_BAR;
            PG8_LDB(B0, 1, 0); PG8_SCHED; PG8_LDA(At, 1, 0); PG8_STAGE(PG8_SA(0, 1), a2 + hstep, voffA);
            PG8_WAIT_L(8); PG8_BAR; PG8_WAIT_L(0); PG8_MMA(0, 0, At, B0); PG8_BAR; PG8_SCHED;
            PG8_LDB(B1, 1, 1); PG8_STAGE(PG8_SB(1, 0), b3, voffB);
            PG8_BAR; PG8_WAIT_L(0); PG8_MMA(0, 1, At, B1); PG8_BAR;
            PG8_LDA(At, 1, 1); PG8_STAGE(PG8_SA(1, 0), a3, voffA);
            PG8_BAR; PG8_WAIT_L(0); PG8_MMA(1, 0, At, B0); PG8_BAR; PG8_SCHED;
            PG8_STAGE(PG8_SB(1, 1), b3 + bhstep, voffB);
            PG8_WAIT_V(6); PG8_BAR; PG8_MMA(1, 1, At, B1); PG8_BAR;
            }
        }
        if constexpr (ALIGN_EPI) { if (wr == 0) PG8_BAR; }
        if constexpr (!Epi::AFTER_DRAIN) { E(acc, cur, wr, wc, fr, fq); S.done(cur); }
        if (!has_next) break;
#pragma unroll
        for (int a = 0; a < 2; ++a)
#pragma unroll
            for (int b = 0; b < 2; ++b)
#pragma unroll
                for (int m = 0; m < 4; ++m)
#pragma unroll
                    for (int n = 0; n < 2; ++n) acc[a][b][m][n] = (f32x4){0.f, 0.f, 0.f, 0.f};
        cur = nxt; cA = nA; cB = nB; ++ui;
        if constexpr (ALIGN_EPI) { if (wr == 1) PG8_BAR; }
    }
    PG8_WAIT_V(0);
    if constexpr (!ALIGN_EPI) { if (wr == 0) PG8_BAR; }
    PG8_BAR;
    if constexpr (Epi::AFTER_DRAIN) { E.fused(acc, cur, wr, wc, fr, fq, lds, wid, lane); S.done(cur); }
#undef PG8_SA
#undef PG8_SB
#undef PG8_STAGE
#undef PG8_LDA
#undef PG8_LDB
#undef PG8_MMA
#undef PG8_WAIT_V
#undef PG8_WAIT_L
#undef PG8_BAR
#undef PG8_SCHED
}
}

#define LAS __attribute__((address_space(3)))
typedef unsigned short bf16;
typedef unsigned v4u __attribute__((ext_vector_type(4)));
typedef unsigned v2u __attribute__((ext_vector_type(2)));
typedef float f32x4 __attribute__((ext_vector_type(4)));
#define LDS_WAIT() asm volatile("s_waitcnt lgkmcnt(0)" ::: "memory")
__device__ __forceinline__ unsigned f2bf(float f) { unsigned u = __builtin_bit_cast(unsigned, f); return (u + 0x7fffu + ((u >> 16) & 1u)) >> 16; }
__device__ __forceinline__ unsigned pk2(float lo, float hi) { return f2bf(lo) | (f2bf(hi) << 16); }
__device__ __forceinline__ float bf2f(unsigned short b) { return __builtin_bit_cast(float, (unsigned)b << 16); }
__device__ __forceinline__ float bflo(unsigned w) { return __builtin_bit_cast(float, w << 16); }
__device__ __forceinline__ float bfhi(unsigned w) { return __builtin_bit_cast(float, w & 0xffff0000u); }
__device__ __forceinline__ float wave_sum(float v) {
#pragma unroll
    for (int o = 1; o < 64; o <<= 1) v += __shfl_xor(v, o);
    return v;
}

constexpr size_t MiB = 1u << 20;
constexpr size_t MD = (size_t)M * D;
constexpr size_t WS_CTL = 0;
constexpr size_t WS_MOD = 1 * MiB;
constexpr size_t WS_COS = 2 * MiB, WS_SIN = 3 * MiB;
constexpr size_t WS_GATES = 4 * MiB;
constexpr size_t WS_GTAB = 5 * MiB;
constexpr size_t WS_WQKV = 8 * MiB;
constexpr size_t WS_WO = WS_WQKV + (size_t)QKV_W * D * 2;
constexpr size_t WS_WIN = WS_WO + (size_t)D * D * 2;
constexpr size_t WS_WMO = WS_WIN + (size_t)ML_INP * D * 2;
constexpr size_t WS_W1 = WS_WMO + (size_t)D * D * 2;
constexpr size_t WS_W2 = WS_W1 + (size_t)2 * DFF * D * 2;
constexpr size_t WS_H = WS_W2 + (size_t)2 * DFF * D * 2;
constexpr size_t WS_BIG = WS_H + MD * 2;
constexpr size_t WS_AO = WS_BIG + (size_t)M * DFF * 2;
constexpr size_t WS_Z = WS_AO + MD * 2;
constexpr size_t WS_X1 = WS_Z + MD * 4;
constexpr size_t WS_X2 = WS_X1 + MD * 4;
constexpr size_t WS_HZ = WS_X2 + MD * 4;
constexpr size_t WS_S = WS_HZ + 2 * MD * 2;
constexpr size_t WS_END = WS_S + (size_t)BATCH * ML_H * 32 * 64 * 64 * 4;
constexpr int LDS_BYTES = 147456;

struct Args { const float* in[23]; float* out; unsigned char* ws; int ph_lo, ph_hi; };
enum { I_X = 0, I_C, I_POS, I_AWQKV, I_ABQKV, I_ASINK, I_AWO, I_ABO, I_MWIN, I_MBIN, I_MNW, I_MWO, I_MBO, I_MODW, I_MODB, I_W1, I_B1, I_W2, I_B2, I_LNMG, I_LNMB, I_LNFG, I_LNFB };

__device__ __forceinline__ void phase_mod(const Args& a, LAS unsigned char* lds) {
    LAS float* sc = (LAS float*)lds;
    LAS float* red = (LAS float*)(lds + 32768);
    const float* c = a.in[I_C]; const float* mod_w = a.in[I_MODW]; const float* mod_b = a.in[I_MODB];
    float* mod = (float*)(a.ws + WS_MOD);
    const int tid = threadIdx.x, G = gridDim.x;
    for (int i = tid; i < BATCH * D; i += NTHREADS) { const float v = c[i]; sc[i] = v / (1.f + __expf(-v)); }
    __syncthreads();
    const int jj = tid & 31, ks = tid >> 5;
    for (int item = blockIdx.x; item < 2 * (6 * D / 32); item += G) {
        const int l = item / (6 * D / 32), j0 = (item % (6 * D / 32)) * 32;
        const float* w = mod_w + (size_t)l * D * (6 * D) + j0 + jj;
        float a0 = 0.f, a1 = 0.f, a2 = 0.f, a3 = 0.f;
#pragma unroll 16
        for (int k = ks * 128; k < ks * 128 + 128; ++k) { const float wv = w[(size_t)k * (6 * D)]; a0 += sc[k] * wv; a1 += sc[D + k] * wv; a2 += sc[2 * D + k] * wv; a3 += sc[3 * D + k] * wv; }
        red[(ks * 4 + 0) * 32 + jj] = a0; red[(ks * 4 + 1) * 32 + jj] = a1; red[(ks * 4 + 2) * 32 + jj] = a2; red[(ks * 4 + 3) * 32 + jj] = a3;
        __syncthreads();
        if (tid < 128) { const int b = tid >> 5; float s = 0.f;
#pragma unroll
            for (int q = 0; q < 16; ++q) s += red[(q * 4 + b) * 32 + jj];
            mod[((size_t)l * BATCH + b) * (6 * D) + j0 + jj] = s + mod_b[(size_t)l * 6 * D + j0 + jj]; }
        __syncthreads();
    }
    const int* pos = (const int*)a.in[I_POS]; float* cosT = (float*)(a.ws + WS_COS); float* sinT = (float*)(a.ws + WS_SIN);
    for (int i = blockIdx.x * NTHREADS + tid; i < M * 32; i += G * NTHREADS) {
        const int p = i & 31, row = i >> 5;
        const float inv_freq = 1.0f / powf(10000.0f, (float)(2 * p) / 64.0f);
        const float ang = (float)pos[row] * inv_freq;
        cosT[i] = cosf(ang); sinT[i] = sinf(ang);
    }
}

__device__ __forceinline__ void transpose_item(const float* W, int K, int pitch, int nblk, bf16* WT, LAS float* scr, int item, int lane) {
    const int kb = item / nblk, nb = item % nblk, k0 = 64 * kb, n0 = 32 * nb;
#pragma unroll 8
    for (int i = 0; i < 32; ++i) { const int kk = 2 * i + (lane >> 5); scr[kk * 33 + (lane & 31)] = W[(size_t)(k0 + kk) * pitch + n0 + (lane & 31)]; }
    LDS_WAIT(); asm volatile("" ::: "memory");
    const int c = lane & 7;
#pragma unroll
    for (int j = 0; j < 4; ++j) { const int n = (lane >> 3) + 8 * j; const LAS float* s = scr + (8 * c) * 33 + n;
        v4u o; o.x = pk2(s[0 * 33], s[1 * 33]); o.y = pk2(s[2 * 33], s[3 * 33]); o.z = pk2(s[4 * 33], s[5 * 33]); o.w = pk2(s[6 * 33], s[7 * 33]);
        *(v4u*)(WT + (size_t)(n0 + n) * K + k0 + 8 * c) = o; }
    LDS_WAIT(); asm volatile("" ::: "memory");
}
__device__ __forceinline__ void phase_prep(const Args& a, LAS unsigned char* lds) {
    const int tid = threadIdx.x, lane = tid & 63, wave = __builtin_amdgcn_readfirstlane(tid >> 6), G = gridDim.x;
    LAS float* scr = (LAS float*)(lds + wave * 16384);
    const int gw = blockIdx.x * NWAVES + wave, NGW = G * NWAVES;
    constexpr int I0 = (D / 64) * (QKV_W / 32), I1 = (D / 64) * (D / 32), I2 = (D / 64) * (ML_INP / 32), I3 = I1, I4 = (D / 64) * (DFF / 32), I6 = (DFF / 64) * (D / 32);
    constexpr int NITEMS = I0 + I1 + I2 + I3 + 2 * I4 + 2 * I6;
    for (int it = gw; it < NITEMS; it += NGW) {
        int r = it;
        if (r < I0) { transpose_item(a.in[I_AWQKV], D, QKV_W, QKV_W / 32, (bf16*)(a.ws + WS_WQKV), scr, r, lane); continue; } r -= I0;
        if (r < I1) { transpose_item(a.in[I_AWO], D, D, D / 32, (bf16*)(a.ws + WS_WO), scr, r, lane); continue; } r -= I1;
        if (r < I2) { transpose_item(a.in[I_MWIN], D, ML_IN, ML_INP / 32, (bf16*)(a.ws + WS_WIN), scr, r, lane); continue; } r -= I2;
        if (r < I3) { transpose_item(a.in[I_MWO], D, D, D / 32, (bf16*)(a.ws + WS_WMO), scr, r, lane); continue; } r -= I3;
        if (r < 2 * I4) { const int l = r / I4; transpose_item(a.in[I_W1] + (size_t)l * D * DFF, D, DFF, DFF / 32, (bf16*)(a.ws + WS_W1) + (size_t)l * DFF * D, scr, r % I4, lane); continue; } r -= 2 * I4;
        { const int l = r / I6; transpose_item(a.in[I_W2] + (size_t)l * DFF * D, DFF, D, D / 32, (bf16*)(a.ws + WS_W2) + (size_t)l * D * DFF, scr, r % I6, lane); }
    }
    const float* x = a.in[I_X]; const float* mod = (const float*)(a.ws + WS_MOD); bf16* h = (bf16*)(a.ws + WS_H);
    for (size_t i = (size_t)blockIdx.x * NTHREADS + tid; i < MD / 4; i += (size_t)G * NTHREADS) {
        const int row = (int)(i / (D / 4)), c4 = (int)(i % (D / 4)) * 4, b = row / SEQ;
        const f32x4 xv = *(const f32x4*)(x + i * 4), sh = *(const f32x4*)(mod + (size_t)b * 6 * D + c4), sc = *(const f32x4*)(mod + (size_t)b * 6 * D + D + c4);
        const f32x4 hv = xv * (sc + 1.0f) + sh;
        v2u o; o.x = pk2(hv[0], hv[1]); o.y = pk2(hv[2], hv[3]);
        *(v2u*)(h + i * 4) = o;
    }
}

template <bool HAS_H, bool GATES>
__device__ __forceinline__ void phase_ln(const Args& a, LAS unsigned char* lds, const float* z, const float* g, const float* bta, float* xo, const float* modl, int sh_off, int sc_off) {
    const int tid = threadIdx.x, lane = tid & 63, wave = __builtin_amdgcn_readfirstlane(tid >> 6), G = gridDim.x;
    bf16* h = (bf16*)(a.ws + WS_H);
    LAS float* wgt = (LAS float*)lds;
    if (GATES) {
        const float* w_in = a.in[I_MWIN];
        for (int i = tid; i < 16 * D; i += NTHREADS) { const int k = i >> 4, gi = i & 15; wgt[gi * D + k] = w_in[(size_t)k * ML_IN + ML_INP + gi]; }
        __syncthreads();
    }
    const int gw = blockIdx.x * NWAVES + wave, NGW = G * NWAVES;
    for (int row = gw; row < M; row += NGW) {
        const int b = row / SEQ;
        const f32x4* zr = (const f32x4*)(z + (size_t)row * D) + lane;
        f32x4 v[8]; float s = 0.f;
#pragma unroll
        for (int j = 0; j < 8; ++j) { v[j] = zr[64 * j]; s += (v[j][0] + v[j][1]) + (v[j][2] + v[j][3]); }
        const float mean = wave_sum(s) * (1.f / D); float s2 = 0.f;
#pragma unroll
        for (int j = 0; j < 8; ++j) { v[j] = v[j] - mean; s2 += (v[j][0] * v[j][0] + v[j][1] * v[j][1]) + (v[j][2] * v[j][2] + v[j][3] * v[j][3]); }
        const float rstd = 1.0f / sqrtf(wave_sum(s2) * (1.f / D) + LN_EPS);
#pragma unroll
        for (int j = 0; j < 8; ++j) { const int col = 4 * (64 * j + lane);
            v[j] = v[j] * rstd * *(const f32x4*)(g + col) + *(const f32x4*)(bta + col);
            *(f32x4*)(xo + (size_t)row * D + col) = v[j];
            if (HAS_H) { const float* mr = modl + (size_t)b * 6 * D;
                v[j] = v[j] * (*(const f32x4*)(mr + sc_off + col) + 1.0f) + *(const f32x4*)(mr + sh_off + col);
                v2u o; o.x = pk2(v[j][0], v[j][1]); o.y = pk2(v[j][2], v[j][3]);
                *(v2u*)(h + (size_t)row * D + col) = o; } }
        if (GATES) {
            float* gates = (float*)(a.ws + WS_GATES); const float* b_in = a.in[I_MBIN];
            float mine = 0.f;
#pragma unroll 1
            for (int gi = 0; gi < 16; ++gi) { float acc = 0.f;
#pragma unroll
                for (int j = 0; j < 8; ++j) { const f32x4 w = *(const LAS f32x4*)(wgt + gi * D + 4 * (64 * j + lane)); acc += (v[j][0] * w[0] + v[j][1] * w[1]) + (v[j][2] * w[2] + v[j][3] * w[3]); }
                acc = wave_sum(acc); if (lane == gi) mine = acc; }
            if (lane < 16) gates[(size_t)row * 16 + lane] = mine + b_in[ML_INP + lane];
        }
    }
    if (GATES) __syncthreads();
}

__device__ __forceinline__ void phase_headnorm(const Args& a) {
    const int tid = threadIdx.x, lane = tid & 63, wave = __builtin_amdgcn_readfirstlane(tid >> 6), G = gridDim.x;
    const bf16* hz = (const bf16*)(a.ws + WS_HZ); const bf16* proj = (const bf16*)(a.ws + WS_BIG); bf16* ym = (bf16*)(a.ws + WS_AO); const float* nw = a.in[I_MNW];
    const int gw = blockIdx.x * NWAVES + wave, NGW = G * NWAVES;
    for (int it = gw; it < M * ML_H; it += NGW) {
        const int row = it >> 2, hh = it & 3; const size_t off = (size_t)row * D + hh * ML_DV + lane * 8;
        const v4u f = *(const v4u*)(hz + off), bw = *(const v4u*)(hz + MD + off), ov = *(const v4u*)(proj + (size_t)row * ML_INP + 4096 + hh * ML_DV + lane * 8);
        float v[8]; float s = 0.f;
#pragma unroll
        for (int e = 0; e < 4; ++e) { v[2 * e] = bflo(f[e]) + bflo(bw[e]); v[2 * e + 1] = bfhi(f[e]) + bfhi(bw[e]); s += v[2 * e] + v[2 * e + 1]; }
        const float mean = wave_sum(s) * (1.f / ML_DV); float s2 = 0.f;
#pragma unroll
        for (int e = 0; e < 8; ++e) { v[e] -= mean; s2 += v[e] * v[e]; }
        const float rstd = 1.0f / sqrtf(wave_sum(s2) * (1.f / ML_DV) + HN_EPS);
        const f32x4 w0 = *(const f32x4*)(nw + hh * ML_DV + lane * 8), w1 = *(const f32x4*)(nw + hh * ML_DV + lane * 8 + 4);
        float y[8];
#pragma unroll
        for (int e = 0; e < 8; ++e) { const float og = (e & 1) ? bfhi(ov[e >> 1]) : bflo(ov[e >> 1]); const float wv = e < 4 ? w0[e] : w1[e - 4];
            y[e] = (1.f / (1.f + __expf(-og))) * (v[e] * rstd * wv); }
        v4u o; o.x = pk2(y[0], y[1]); o.y = pk2(y[2], y[3]); o.z = pk2(y[4], y[5]); o.w = pk2(y[6], y[7]);
        *(v4u*)(ym + off) = o;
    }
}

typedef short bf16x8_t __attribute__((ext_vector_type(8)));
typedef short s16x4_t __attribute__((ext_vector_type(4)));
typedef float f32x16 __attribute__((ext_vector_type(16)));
constexpr int AT_KCS = 6160, AT_VDS = 24640, AT_K = 0, AT_V = 8 * AT_KCS, AT_WS = AT_V + 2 * AT_VDS;
static_assert(AT_WS + NWAVES * 64 * 4 <= LDS_BYTES, "attention LDS");
__device__ __forceinline__ int crow(int r, int hi) { return (r & 3) + 8 * (r >> 2) + 4 * hi; }
__device__ __forceinline__ s16x4_t lds_tr16(const LAS unsigned char* p) { return __builtin_bit_cast(s16x4_t, __builtin_amdgcn_ds_read_tr16_b64_v4i16((LAS s16x4_t*)p)); }
__device__ __forceinline__ unsigned cvtpk(float lo, float hi) { unsigned r; asm volatile("v_cvt_pk_bf16_f32 %0, %1, %2" : "=v"(r) : "v"(lo), "v"(hi)); return r; }

__device__ __forceinline__ void phase_attn(const Args& a, LAS unsigned char* lds) {
    const int tid = threadIdx.x, lane = tid & 63, r32 = lane & 31, hi = lane >> 5, wid = __builtin_amdgcn_readfirstlane(tid >> 6), G = gridDim.x;
    const bf16* qkv = (const bf16*)(a.ws + WS_BIG); bf16* O = (bf16*)(a.ws + WS_AO); const float* sink = a.in[I_ASINK];
    LAS float* wsf = (LAS float*)(lds + AT_WS) + wid * 64;
    const LAS unsigned char* kfrag0 = lds + AT_K + hi * AT_KCS + r32 * 16;
    const LAS unsigned char* vfrag0 = lds + AT_V + ((lane >> 4) & 1) * 32 + (lane & 3) * 8 + (4 * hi + ((lane & 15) >> 2)) * 64;
    for (int u = blockIdx.x; u < BATCH * NKVH * (SEQ / 128); u += G) {
        const int kvh = u & 7, nb = (u >> 3) & 15, b = u >> 7, blk = nb * 128;
        __syncthreads();
#pragma unroll
        for (int i = 0; i < 6; ++i) {
            const int p = i * NTHREADS + tid, key = p >> 3, c = p & 7, kpos = blk - 128 + key;
            v4u kv = (v4u){0u, 0u, 0u, 0u}, vv = (v4u){0u, 0u, 0u, 0u};
            if ((unsigned)kpos < (unsigned)SEQ) { const bf16* src = qkv + ((size_t)b * SEQ + kpos) * QKV_W + 2048 + kvh * 64 + c * 8; kv = *(const v4u*)src; vv = *(const v4u*)(src + 512); }
            *(LAS v4u*)(lds + AT_K + c * AT_KCS + key * 16) = kv;
            *(LAS v4u*)(lds + AT_V + (c >> 2) * AT_VDS + key * 64 + (c & 3) * 16) = vv;
        }
        __syncthreads();
        const int hq = kvh * 4 + (wid >> 1);
        const float sink2 = sink[hq] * LOG2E;
        for (int sbi = 0; sbi < 2; ++sbi) {
            const int sb = 2 * (wid & 1) + sbi, qo = 32 * sb, tlo = sb >> 1;
            const bf16* qrow = qkv + ((size_t)b * SEQ + blk + qo + r32) * QKV_W + hq * 64 + hi * 8;
            bf16x8_t qr[4];
#pragma unroll
            for (int d0 = 0; d0 < 4; ++d0) qr[d0] = *(const bf16x8_t*)(qrow + d0 * 16);
            float m = sink2, l = hi ? 0.f : 1.f;
            f32x16 o0 = {}, o1 = {};
            for (int kt = tlo; kt < tlo + 5; ++kt) {
                f32x16 p0 = {}, p1 = {};
                const LAS unsigned char* kb = kfrag0 + kt * 1024;
#pragma unroll
                for (int d0 = 0; d0 < 4; ++d0) {
                    const bf16x8_t k0 = *(const LAS bf16x8_t*)(kb + d0 * 2 * AT_KCS), k1 = *(const LAS bf16x8_t*)(kb + d0 * 2 * AT_KCS + 512);
                    p0 = __builtin_amdgcn_mfma_f32_32x32x16_bf16(k0, qr[d0], p0, 0, 0, 0);
                    p1 = __builtin_amdgcn_mfma_f32_32x32x16_bf16(k1, qr[d0], p1, 0, 0, 0);
                }
                const int dbase = 64 * kt - 128 - qo - r32 + 4 * hi, pbase = blk - 128 + 64 * kt + 4 * hi;
                float rm = -1e30f;
#pragma unroll
                for (int r = 0; r < 16; ++r) {
                    const int cr = (r & 3) + 8 * (r >> 2), d0_ = dbase + cr, d1_ = d0_ + 32, kp0 = pbase + cr, kp1 = kp0 + 32;
                    const bool v0 = (d0_ <= 128) && (d0_ >= -128) && ((unsigned)kp0 < (unsigned)SEQ), v1 = (d1_ <= 128) && (d1_ >= -128) && ((unsigned)kp1 < (unsigned)SEQ);
                    p0[r] = v0 ? p0[r] : -1e30f; p1[r] = v1 ? p1[r] : -1e30f;
                    rm = fmaxf(rm, fmaxf(p0[r], p1[r]));
                }
                rm = fmaxf(rm, __shfl_xor(rm, 32));
                const float mn = fmaxf(m, rm), f = __builtin_amdgcn_exp2f(m - mn);
                m = mn;
                float ps = 0.f;
#pragma unroll
                for (int r = 0; r < 16; ++r) { p0[r] = __builtin_amdgcn_exp2f(p0[r] - mn); p1[r] = __builtin_amdgcn_exp2f(p1[r] - mn); ps += p0[r] + p1[r]; }
                l = l * f + ps;
                if (hi == 0) wsf[r32] = f;
                LDS_WAIT(); asm volatile("" ::: "memory");
#pragma unroll
                for (int r = 0; r < 16; ++r) { const float fr_ = wsf[crow(r, hi)]; o0[r] *= fr_; o1[r] *= fr_; }
                asm volatile("" ::: "memory");
                v4u pw[4];
#pragma unroll
                for (int s = 0; s < 2; ++s) {
                    pw[s] = (v4u){cvtpk(p0[8 * s], p0[8 * s + 1]), cvtpk(p0[8 * s + 2], p0[8 * s + 3]), cvtpk(p0[8 * s + 4], p0[8 * s + 5]), cvtpk(p0[8 * s + 6], p0[8 * s + 7])};
                    pw[2 + s] = (v4u){cvtpk(p1[8 * s], p1[8 * s + 1]), cvtpk(p1[8 * s + 2], p1[8 * s + 3]), cvtpk(p1[8 * s + 4], p1[8 * s + 5]), cvtpk(p1[8 * s + 6], p1[8 * s + 7])};
                }
                const LAS unsigned char* vb = vfrag0 + kt * 4096;
#pragma unroll
                for (int ks = 0; ks < 4; ++ks) {
                    const s16x4_t a0 = lds_tr16(vb + ks * 1024), a1 = lds_tr16(vb + ks * 1024 + 512), c0 = lds_tr16(vb + AT_VDS + ks * 1024), c1 = lds_tr16(vb + AT_VDS + ks * 1024 + 512);
                    const bf16x8_t vf0 = (bf16x8_t){a0[0], a0[1], a0[2], a0[3], a1[0], a1[1], a1[2], a1[3]}, vf1 = (bf16x8_t){c0[0], c0[1], c0[2], c0[3], c1[0], c1[1], c1[2], c1[3]};
                    const bf16x8_t pa = __builtin_bit_cast(bf16x8_t, pw[ks]);
                    o0 = __builtin_amdgcn_mfma_f32_32x32x16_bf16(pa, vf0, o0, 0, 0, 0);
                    o1 = __builtin_amdgcn_mfma_f32_32x32x16_bf16(pa, vf1, o1, 0, 0, 0);
                }
            }
            l += __shfl_xor(l, 32);
            if (hi == 0) wsf[32 + r32] = l;
            LDS_WAIT(); asm volatile("" ::: "memory");
            bf16* orow = O + ((size_t)b * SEQ + blk + qo) * D + hq * 64 + r32;
#pragma unroll
            for (int r = 0; r < 16; ++r) { const float il = 1.0f / wsf[32 + crow(r, hi)]; const int q = crow(r, hi);
                orow[(size_t)q * D] = (bf16)f2bf(o0[r] * il); orow[(size_t)q * D + 32] = (bf16)f2bf(o1[r] * il); }
            asm volatile("" ::: "memory");
        }
    }
}

typedef float f32x4_t __attribute__((ext_vector_type(4)));
constexpr int NSEQ = 2 * BATCH * ML_H;
constexpr size_t GT_B = 0, GT_M = (size_t)NSEQ * SEQ * 4, GT_T = 2 * GT_M, GT_C = 3 * GT_M;
static_assert(GT_C + NSEQ * 32 * 2 * 4 <= 3 * MiB, "gate tables");

__device__ __forceinline__ void phase_mlstm_pre(const Args& a) {
    const int tid = threadIdx.x, lane = tid & 63, wave = __builtin_amdgcn_readfirstlane(tid >> 6), G = gridDim.x;
    const float* gates = (const float*)(a.ws + WS_GATES);
    unsigned char* gt = a.ws + WS_GTAB;
    const int gw = blockIdx.x * NWAVES + wave;
    if (gw < NSEQ) {
        const int seq = gw, h = seq & 3, b = (seq >> 2) & 3, dir = seq >> 4;
        float* TB = (float*)(gt + GT_B) + (size_t)seq * SEQ; float* TM = (float*)(gt + GT_M) + (size_t)seq * SEQ; float* TT = (float*)(gt + GT_T) + (size_t)seq * SEQ; float* TC = (float*)(gt + GT_C) + (size_t)seq * 64;
        float mc = -1e30f;
        for (int cc = 0; cc < 32; ++cc) {
            const int c = dir ? 31 - cc : cc, t = c * 64 + (dir ? 63 - lane : lane);
            const float* gr = gates + ((size_t)b * SEQ + t) * 16;
            const float li = gr[(dir ? 8 : 0) + h], fp = gr[(dir ? 12 : 4) + h];
            float g = fminf(fp, 0.f) - log1pf(expf(-fabsf(fp)));
#pragma unroll
            for (int o = 1; o < 64; o <<= 1) { const float v = __shfl_up(g, o); if (lane >= o) g += v; }
            const float bb = li - g; float pm = bb;
#pragma unroll
            for (int o = 1; o < 64; o <<= 1) { const float v = __shfl_up(pm, o); if (lane >= o) pm = fmaxf(pm, v); }
            const float Mx = fmaxf(mc, pm);
            TB[t] = bb; TM[t] = Mx; TT[t] = g + Mx;
            const float Gs = __shfl(g, 63), Ml = __shfl(Mx, 63);
            if (lane == 0) { TC[c * 2] = mc; TC[c * 2 + 1] = Ml; }
            mc = Gs + Ml;
        }
    }
    const bf16* proj = (const bf16*)(a.ws + WS_BIG); float* Sg = (float*)(a.ws + WS_S);
    const int c16 = lane & 15, q4 = lane >> 4, tt = wave >> 1, st0 = 2 * (wave & 1);
    for (int it = blockIdx.x; it < BATCH * ML_H * 32; it += G) {
        const int c = it & 31, h = (it >> 5) & 3, b = it >> 7;
        const bf16* qp = proj + ((size_t)b * SEQ + c * 64 + tt * 16 + c16) * ML_INP + h * ML_DK + q4 * 8;
        const bf16* kp0 = proj + ((size_t)b * SEQ + c * 64 + st0 * 16 + c16) * ML_INP + 1024 + h * ML_DK + q4 * 8;
        const bf16* kp1 = kp0 + (size_t)16 * ML_INP;
        f32x4_t acc0 = {}, acc1 = {};
#pragma unroll
        for (int ks = 0; ks < 8; ++ks) {
            const bf16x8_t af = *(const bf16x8_t*)(qp + ks * 32), b0 = *(const bf16x8_t*)(kp0 + ks * 32), b1 = *(const bf16x8_t*)(kp1 + ks * 32);
            acc0 = __builtin_amdgcn_mfma_f32_16x16x32_bf16(af, b0, acc0, 0, 0, 0);
            acc1 = __builtin_amdgcn_mfma_f32_16x16x32_bf16(af, b1, acc1, 0, 0, 0);
        }
        float* sp = Sg + (size_t)it * 4096 + (size_t)(tt * 16 + 4 * q4) * 64 + st0 * 16 + c16;
#pragma unroll
        for (int r = 0; r < 4; ++r) { sp[r * 64] = acc0[r]; sp[r * 64 + 16] = acc1[r]; }
    }
}

constexpr int ML_QST = 528, ML_VST = 176, ML_SST = 144;
constexpr int ML_QS = 0, ML_KS = ML_QS + 64 * ML_QST, ML_VS = ML_KS + 64 * ML_QST, ML_VW = ML_VS + 64 * ML_VST, ML_SC = ML_VW + 64 * ML_VST, ML_CT = ML_SC + 64 * ML_SST, ML_SCAL = ML_CT + 80 * ML_QST;
static_assert(ML_SCAL + 4 * 64 * 4 <= LDS_BYTES, "mLSTM LDS");
__device__ __forceinline__ void phase_mlstm_scan(const Args& a, LAS unsigned char* lds) {
    const int tid = threadIdx.x, lane = tid & 63, wave = __builtin_amdgcn_readfirstlane(tid >> 6), G = gridDim.x;
    const int c16 = lane & 15, q4 = lane >> 4;
    const bf16* proj = (const bf16*)(a.ws + WS_BIG); const float* Sg = (const float*)(a.ws + WS_S); bf16* hz = (bf16*)(a.ws + WS_HZ);
    const unsigned char* gt = a.ws + WS_GTAB;
    LAS float* s_ea = (LAS float*)(lds + ML_SCAL); LAS float* s_emt = s_ea + 64;
    for (int item = blockIdx.x; item < NSEQ * 8; item += G) {
        const int sl = item & 7, seq = item >> 3, h = seq & 3, b = (seq >> 2) & 3, dir = seq >> 4;
        const float* TB = (const float*)(gt + GT_B) + (size_t)seq * SEQ; const float* TM = (const float*)(gt + GT_M) + (size_t)seq * SEQ; const float* TT = (const float*)(gt + GT_T) + (size_t)seq * SEQ; const float* TC = (const float*)(gt + GT_C) + (size_t)seq * 64;
        __syncthreads();
        for (int i = tid; i < 80 * ML_QST / 16; i += NTHREADS) *(LAS v4u*)(lds + ML_CT + i * 16) = (v4u){0u, 0u, 0u, 0u};
        f32x4_t cacc[2][5];
#pragma unroll
        for (int i = 0; i < 2; ++i)
#pragma unroll
            for (int j = 0; j < 5; ++j) cacc[i][j] = (f32x4_t){0.f, 0.f, 0.f, 0.f};
        for (int cc = 0; cc < 32; ++cc) {
            const int c = dir ? 31 - cc : cc; const size_t row0 = (size_t)b * SEQ + c * 64;
            const float mc = TC[c * 2], Mlast = TC[c * 2 + 1];
#pragma unroll
            for (int i = 0; i < 4; ++i) { const int p = i * NTHREADS + tid, r = p >> 5, ch = p & 31;
                const bf16* src = proj + (row0 + r) * ML_INP + h * ML_DK + ch * 8;
                *(LAS v4u*)(lds + ML_QS + r * ML_QST + ch * 16) = *(const v4u*)src;
                *(LAS v4u*)(lds + ML_KS + r * ML_QST + ch * 16) = *(const v4u*)(src + 1024); }
            { const int r = tid >> 3, ch = tid & 7;
              const v4u vv = *(const v4u*)(proj + (row0 + r) * ML_INP + 2048 + h * ML_DV + sl * 64 + ch * 8);
              const float w = expf(TB[c * 64 + r] - Mlast);
              *(LAS v4u*)(lds + ML_VS + r * ML_VST + ch * 16) = vv;
              v4u ws_; ws_.x = pk2(bflo(vv.x) * w, bfhi(vv.x) * w); ws_.y = pk2(bflo(vv.y) * w, bfhi(vv.y) * w); ws_.z = pk2(bflo(vv.z) * w, bfhi(vv.z) * w); ws_.w = pk2(bflo(vv.w) * w, bfhi(vv.w) * w);
              *(LAS v4u*)(lds + ML_VW + r * ML_VST + ch * 16) = ws_;
              if (ch == 0) { *(LAS v4u*)(lds + ML_VS + r * ML_VST + 128) = (v4u){0x3f80u, 0u, 0u, 0u}; *(LAS v4u*)(lds + ML_VS + r * ML_VST + 144) = (v4u){0u, 0u, 0u, 0u};
                             *(LAS v4u*)(lds + ML_VW + r * ML_VST + 128) = (v4u){f2bf(w), 0u, 0u, 0u}; *(LAS v4u*)(lds + ML_VW + r * ML_VST + 144) = (v4u){0u, 0u, 0u, 0u}; } }
            { const int t = tid >> 3, s0 = (tid & 7) * 8;
              const float* sp = Sg + ((size_t)((b * ML_H + h) * 32 + c)) * 4096 + t * 64 + s0;
              const f32x4_t sa = *(const f32x4_t*)sp, sb = *(const f32x4_t*)(sp + 4), ba = *(const f32x4_t*)(TB + c * 64 + s0), bb = *(const f32x4_t*)(TB + c * 64 + s0 + 4);
              const float Mt = TM[c * 64 + t]; float e[8];
#pragma unroll
              for (int j = 0; j < 8; ++j) { const int s = s0 + j; const bool ok = dir ? (s >= t) : (s <= t); const float sv = j < 4 ? sa[j] : sb[j - 4], bv = j < 4 ? ba[j] : bb[j - 4];
                  e[j] = ok ? sv * __expf(bv - Mt) : 0.f; }
              v4u o; o.x = pk2(e[0], e[1]); o.y = pk2(e[2], e[3]); o.z = pk2(e[4], e[5]); o.w = pk2(e[6], e[7]);
              *(LAS v4u*)(lds + ML_SC + t * ML_SST + s0 * 2) = o; }
            if (tid < 64) { s_ea[tid] = expf(mc - TM[c * 64 + tid]); s_emt[tid] = expf(-TT[c * 64 + tid]); }
            const float decay = expf(mc - Mlast);
            __syncthreads();
            {
                const int tt = wave >> 1, j0 = 2 * (wave & 1);
                f32x4_t ai[3], aa[3];
#pragma unroll
                for (int j = 0; j < 3; ++j) { ai[j] = (f32x4_t){0.f, 0.f, 0.f, 0.f}; aa[j] = (f32x4_t){0.f, 0.f, 0.f, 0.f}; }
                const LAS unsigned char* qa = lds + ML_QS + (tt * 16 + c16) * ML_QST + q4 * 16;
                const LAS unsigned char* cb0 = lds + ML_CT + (j0 * 16 + c16) * ML_QST + q4 * 16;
                const LAS unsigned char* cb2 = lds + ML_CT + (64 + c16) * ML_QST + q4 * 16;
#pragma unroll
                for (int ks = 0; ks < 8; ++ks) {
                    const bf16x8_t af = *(const LAS bf16x8_t*)(qa + ks * 64);
                    const bf16x8_t b0 = *(const LAS bf16x8_t*)(cb0 + ks * 64), b1 = *(const LAS bf16x8_t*)(cb0 + 16 * ML_QST + ks * 64), b2 = *(const LAS bf16x8_t*)(cb2 + ks * 64);
                    ai[0] = __builtin_amdgcn_mfma_f32_16x16x32_bf16(af, b0, ai[0], 0, 0, 0);
                    ai[1] = __builtin_amdgcn_mfma_f32_16x16x32_bf16(af, b1, ai[1], 0, 0, 0);
                    ai[2] = __builtin_amdgcn_mfma_f32_16x16x32_bf16(af, b2, ai[2], 0, 0, 0);
                }
                const LAS unsigned char* sa_ = lds + ML_SC + (tt * 16 + c16) * ML_SST + q4 * 16;
                const LAS unsigned char* vt = lds + ML_VS + (8 * q4 + (c16 >> 2)) * ML_VST + (c16 & 3) * 8;
#pragma unroll
                for (int ks = 0; ks < 2; ++ks) {
                    const bf16x8_t af = *(const LAS bf16x8_t*)(sa_ + ks * 64);
#pragma unroll
                    for (int j = 0; j < 3; ++j) { const int dvt = j < 2 ? j0 + j : 4;
                        const s16x4_t x0 = lds_tr16(vt + ks * 32 * ML_VST + dvt * 32), x1 = lds_tr16(vt + (ks * 32 + 4) * ML_VST + dvt * 32);
                        const bf16x8_t bf_ = (bf16x8_t){x0[0], x0[1], x0[2], x0[3], x1[0], x1[1], x1[2], x1[3]};
                        aa[j] = __builtin_amdgcn_mfma_f32_16x16x32_bf16(af, bf_, aa[j], 0, 0, 0); }
                }
                bf16* op = hz + (size_t)dir * MD + (row0 + tt * 16 + 4 * q4) * D + h * ML_DV + sl * 64 + j0 * 16 + c16;
#pragma unroll
                for (int r = 0; r < 4; ++r) { const int t = tt * 16 + 4 * q4 + r; const float ea = s_ea[t], emt = s_emt[t];
                    const float den = __shfl(ea * ai[2][r] + aa[2][r], lane & 48);
                    const float inv = 1.0f / fmaxf(fabsf(den), emt);
                    op[(size_t)r * D] = (bf16)f2bf((ea * ai[0][r] + aa[0][r]) * inv); op[(size_t)r * D + 16] = (bf16)f2bf((ea * ai[1][r] + aa[1][r]) * inv); }
            }
            {
#pragma unroll
                for (int i = 0; i < 2; ++i)
#pragma unroll
                    for (int j = 0; j < 5; ++j) cacc[i][j] = cacc[i][j] * decay;
                const LAS unsigned char* kt_ = lds + ML_KS + (8 * q4 + (c16 >> 2)) * ML_QST + (wave * 32 + (c16 & 3) * 4) * 2;
                const LAS unsigned char* vt = lds + ML_VW + (8 * q4 + (c16 >> 2)) * ML_VST + (c16 & 3) * 8;
#pragma unroll
                for (int ks = 0; ks < 2; ++ks) {
                    bf16x8_t af[2];
#pragma unroll
                    for (int i = 0; i < 2; ++i) { const s16x4_t x0 = lds_tr16(kt_ + ks * 32 * ML_QST + i * 32), x1 = lds_tr16(kt_ + (ks * 32 + 4) * ML_QST + i * 32);
                        af[i] = (bf16x8_t){x0[0], x0[1], x0[2], x0[3], x1[0], x1[1], x1[2], x1[3]}; }
#pragma unroll
                    for (int j = 0; j < 5; ++j) { const s16x4_t x0 = lds_tr16(vt + ks * 32 * ML_VST + j * 32), x1 = lds_tr16(vt + (ks * 32 + 4) * ML_VST + j * 32);
                        const bf16x8_t bf_ = (bf16x8_t){x0[0], x0[1], x0[2], x0[3], x1[0], x1[1], x1[2], x1[3]};
                        cacc[0][j] = __builtin_amdgcn_mfma_f32_16x16x32_bf16(af[0], bf_, cacc[0][j], 0, 0, 0);
                        cacc[1][j] = __builtin_amdgcn_mfma_f32_16x16x32_bf16(af[1], bf_, cacc[1][j], 0, 0, 0); }
                }
            }
            __syncthreads();
#pragma unroll
            for (int i = 0; i < 2; ++i)
#pragma unroll
                for (int j = 0; j < 5; ++j) { v2u o; o.x = pk2(cacc[i][j][0], cacc[i][j][1]); o.y = pk2(cacc[i][j][2], cacc[i][j][3]);
                    *(LAS v2u*)(lds + ML_CT + (j * 16 + c16) * ML_QST + (wave * 32 + i * 16 + 4 * q4) * 2) = o; }
        }
    }
}

constexpr int CW_BAR = 4096;
constexpr int MISC_OFF = LDS_BYTES - 64;
#define XB_TMO      128
#define XB_XCNT(j)  (256  + 64 * (j))
#define XB_XSUB(j)  (1280 + 64 * (j))
#define XB_XGEN(j)  (2304 + 64 * (j))
#define XB_TOP      3328
#define XB_TOPGEN   3392
#define XCD_BAR_WORDS 3456
#define XB_SPIN_CAP (1u << 18)

__device__ __forceinline__ unsigned xb_ld(unsigned* p)              { return __hip_atomic_load(p, __ATOMIC_RELAXED, __HIP_MEMORY_SCOPE_AGENT); }
__device__ __forceinline__ unsigned xb_add(unsigned* p, unsigned v) { return __hip_atomic_fetch_add(p, v, __ATOMIC_RELAXED, __HIP_MEMORY_SCOPE_AGENT); }
__device__ __forceinline__ unsigned xb_xcc_id() { return (unsigned)__builtin_amdgcn_s_getreg((3 << 11) | 20) & 0xFu; }
#define XB_SPIN(cond, bar) do { unsigned _sp = 0; while (cond) { __builtin_amdgcn_s_sleep(1); \
    if ((++_sp & 255u) == 0u) { if (xb_ld(&(bar)[XB_TMO])) break; if (_sp > XB_SPIN_CAP) { atomicAdd(&(bar)[XB_TMO], 1u); break; } } } } while (0)

struct XcdBarrier {
    unsigned* bar; unsigned x;
    volatile LAS unsigned* st;
};

__device__ __forceinline__ XcdBarrier xcd_barrier_post(unsigned* bar, volatile LAS unsigned* st) {
    XcdBarrier b; b.bar = bar; b.x = xb_xcc_id(); b.st = st;
    if (threadIdx.x == 0) (void)xb_add(&bar[XB_XCNT(b.x)], 1u);
    return b;
}
__device__ __forceinline__ void xcd_barrier_complete(unsigned* bar, unsigned x, unsigned& nloc, unsigned& nx) {
    const unsigned G = gridDim.x * gridDim.y * gridDim.z;
    unsigned sum, cnt, mine, sp = 0u;
    for (;;) {
        sum = 0u; cnt = 0u; mine = 0u;
#pragma unroll
        for (unsigned j = 0; j < 16; ++j) { const unsigned c = xb_ld(&bar[XB_XCNT(j)]); sum += c; cnt += (c > 0u) ? 1u : 0u; mine = (j == x) ? c : mine; }
        if (sum == G) break;
        __builtin_amdgcn_s_sleep(1);
        if ((++sp & 255u) == 0u) { if (xb_ld(&bar[XB_TMO])) break; if (sp > XB_SPIN_CAP) { atomicAdd(&bar[XB_TMO], 1u); break; } }
    }
    nloc = mine > 0u ? mine : 1u; nx = cnt > 0u ? cnt : 1u;
}

__device__ __forceinline__ void xcd_barrier(const XcdBarrier& b) {
    asm volatile("s_waitcnt vmcnt(0)" ::: "memory");
    __syncthreads();
    if (threadIdx.x == 0) {
        unsigned* bar = b.bar;
        __builtin_amdgcn_s_waitcnt(0);
        unsigned nloc = b.st[0], nx = b.st[1];
        if (nloc == 0u) { xcd_barrier_complete(bar, b.x, nloc, nx); b.st[0] = nloc; b.st[1] = nx; }
        const unsigned old = xb_add(&bar[XB_XSUB(b.x)], 1u);
        const unsigned gen = old / nloc;
        if (old + 1u == (gen + 1u) * nloc) {
            __builtin_amdgcn_fence(__ATOMIC_RELEASE, "agent");
            asm volatile("s_waitcnt vmcnt(0)" ::: "memory");
            const unsigned og = xb_add(&bar[XB_TOP], 1u);
            const unsigned tg = og / nx;
            if (og + 1u == (tg + 1u) * nx) xb_add(&bar[XB_TOPGEN], 1u);
            else XB_SPIN(xb_ld(&bar[XB_TOPGEN]) == tg, bar);
            __builtin_amdgcn_fence(__ATOMIC_ACQUIRE, "agent");
            xb_add(&bar[XB_XGEN(b.x)], 1u);
            asm volatile("s_waitcnt vmcnt(0)" ::: "memory");
        } else {
            XB_SPIN(xb_ld(&bar[XB_XGEN(b.x)]) == gen, bar);
            __builtin_amdgcn_fence(__ATOMIC_ACQUIRE, "agent");
            asm volatile("s_waitcnt vmcnt(0)" ::: "memory");
        }
    }
    __syncthreads();
}

namespace cg = cooperative_groups;
#ifndef REP_TABLE
#define REP_TABLE {1,1,1,1,1,1,1,1,1,1,1,1,1,1,1,1,1,1}
#endif
__device__ constexpr int kRep[18] = REP_TABLE;
__global__ void __launch_bounds__(NTHREADS, 2) mega(Args a) {
    extern __shared__ __attribute__((aligned(16))) unsigned char lds_raw[];
    LAS unsigned char* lds = (LAS unsigned char*)lds_raw;
    cg::grid_group grid = cg::this_grid();
    const int lo = a.ph_lo, hi = a.ph_hi, G = gridDim.x;
#define IN(k) (lo <= (k) && (k) < hi)
    volatile LAS unsigned* misc = (volatile LAS unsigned*)(lds + MISC_OFF);
    if (threadIdx.x < 2) misc[threadIdx.x] = 0u;
    __syncthreads();
    const XcdBarrier xbar = xcd_barrier_post((unsigned*)(a.ws + WS_CTL) + CW_BAR, misc);
#define SEAM(k) do { if (IN(k) && IN((k) + 1)) { if ((k) == 0) grid.sync(); else xcd_barrier(xbar); } } while (0)
    unsigned char* ws = a.ws;
    const float* mod0 = (const float*)(ws + WS_MOD); const float* mod1 = mod0 + (size_t)BATCH * 6 * D;
    bf16* Hb = (bf16*)(ws + WS_H); bf16* BIG = (bf16*)(ws + WS_BIG); bf16* AO = (bf16*)(ws + WS_AO);
    float* Z = (float*)(ws + WS_Z); float* X1 = (float*)(ws + WS_X1); float* X2 = (float*)(ws + WS_X2);

    if (IN(0)) for (int rep_ = 0; rep_ < kRep[0]; ++rep_) { phase_mod(a, lds); } SEAM(0);
    if (IN(1)) for (int rep_ = 0; rep_ < kRep[1]; ++rep_) { phase_prep(a, lds); } SEAM(1);
    if (IN(2)) for (int rep_ = 0; rep_ < kRep[2]; ++rep_) {
        pg8::Gemm g{Hb, (const bf16*)(ws + WS_WQKV), M, QKV_W, D}; pg8::StaticOrder S; S.init(M, QKV_W, G, (int)blockIdx.x);
        pg8::EpiQKV E{BIG, QKV_W, a.in[I_ABQKV], (const float*)(ws + WS_COS), (const float*)(ws + WS_SIN), 8, 10, QSCALE};
        pg8::gemm_phase<pg8::EpiQKV, pg8::StaticOrder, true, true>(lds, g, S, E);
    } SEAM(2);
    if (IN(3)) for (int rep_ = 0; rep_ < kRep[3]; ++rep_) { phase_attn(a, lds); } SEAM(3);
    if (IN(4)) for (int rep_ = 0; rep_ < kRep[4]; ++rep_) {
        pg8::Gemm g{AO, (const bf16*)(ws + WS_WO), M, D, D}; pg8::StaticOrder S; S.init(M, D, G, (int)blockIdx.x);
        pg8::EpiRes E{Z, D, a.in[I_ABO], a.in[I_X], mod0 + 2 * D, 6 * D, SEQ / 256, ALPHA};
        pg8::gemm_phase<pg8::EpiRes, pg8::StaticOrder, true, true>(lds, g, S, E);
    } SEAM(4);
    if (IN(5)) for (int rep_ = 0; rep_ < kRep[5]; ++rep_) { phase_ln<true, false>(a, lds, Z, a.in[I_LNMG], a.in[I_LNMB], X1, mod0, 3 * D, 4 * D); } SEAM(5);
    if (IN(6)) for (int rep_ = 0; rep_ < kRep[6]; ++rep_) {
        pg8::Gemm g{Hb, (const bf16*)(ws + WS_W1), M, DFF, D}; pg8::StaticOrder S; S.init(M, DFF, G, (int)blockIdx.x);
        pg8::EpiBf16<1> E{BIG, DFF, a.in[I_B1], 0, 1.f};
        pg8::gemm_phase<pg8::EpiBf16<1>, pg8::StaticOrder, true, true>(lds, g, S, E);
    } SEAM(6);
    if (IN(7)) for (int rep_ = 0; rep_ < kRep[7]; ++rep_) {
        pg8::Gemm g{BIG, (const bf16*)(ws + WS_W2), M, D, DFF}; pg8::StaticOrder S; S.init(M, D, G, (int)blockIdx.x);
        pg8::EpiRes E{Z, D, a.in[I_B2], X1, mod0 + 5 * D, 6 * D, SEQ / 256, ALPHA};
        pg8::gemm_phase<pg8::EpiRes, pg8::StaticOrder, true, true>(lds, g, S, E);
    } SEAM(7);
    if (IN(8)) for (int rep_ = 0; rep_ < kRep[8]; ++rep_) { phase_ln<true, true>(a, lds, Z, a.in[I_LNFG], a.in[I_LNFB], X2, mod1, 0, D); } SEAM(8);
    if (IN(9)) for (int rep_ = 0; rep_ < kRep[9]; ++rep_) {
        pg8::Gemm g{Hb, (const bf16*)(ws + WS_WIN), M, ML_INP, D}; pg8::StaticOrder S; S.init(M, ML_INP, G, (int)blockIdx.x);
        pg8::EpiBf16<0> E{BIG, ML_INP, a.in[I_MBIN], 4, 0.0625f};
        pg8::gemm_phase<pg8::EpiBf16<0>, pg8::StaticOrder, true, true>(lds, g, S, E);
    } SEAM(9);
    if (IN(10)) for (int rep_ = 0; rep_ < kRep[10]; ++rep_) { phase_mlstm_pre(a); } SEAM(10);
    if (IN(11)) for (int rep_ = 0; rep_ < kRep[11]; ++rep_) { phase_mlstm_scan(a, lds); } SEAM(11);
    if (IN(12)) for (int rep_ = 0; rep_ < kRep[12]; ++rep_) { phase_headnorm(a); } SEAM(12);
    if (IN(13)) for (int rep_ = 0; rep_ < kRep[13]; ++rep_) {
        pg8::Gemm g{AO, (const bf16*)(ws + WS_WMO), M, D, D}; pg8::StaticOrder S; S.init(M, D, G, (int)blockIdx.x);
        pg8::EpiRes E{Z, D, a.in[I_MBO], X2, mod1 + 2 * D, 6 * D, SEQ / 256, ALPHA};
        pg8::gemm_phase<pg8::EpiRes, pg8::StaticOrder, true, true>(lds, g, S, E);
    } SEAM(13);
    if (IN(14)) for (int rep_ = 0; rep_ < kRep[14]; ++rep_) { phase_ln<true, false>(a, lds, Z, a.in[I_LNMG] + D, a.in[I_LNMB] + D, X1, mod1, 3 * D, 4 * D); } SEAM(14);
    if (IN(15)) for (int rep_ = 0; rep_ < kRep[15]; ++rep_) {
        pg8::Gemm g{Hb, (const bf16*)(ws + WS_W1) + (size_t)DFF * D, M, DFF, D}; pg8::StaticOrder S; S.init(M, DFF, G, (int)blockIdx.x);
        pg8::EpiBf16<1> E{BIG, DFF, a.in[I_B1] + DFF, 0, 1.f};
        pg8::gemm_phase<pg8::EpiBf16<1>, pg8::StaticOrder, true, true>(lds, g, S, E);
    } SEAM(15);
    if (IN(16)) for (int rep_ = 0; rep_ < kRep[16]; ++rep_) {
        pg8::Gemm g{BIG, (const bf16*)(ws + WS_W2) + (size_t)D * DFF, M, D, DFF}; pg8::StaticOrder S; S.init(M, D, G, (int)blockIdx.x);
        pg8::EpiRes E{Z, D, a.in[I_B2] + D, X1, mod1 + 5 * D, 6 * D, SEQ / 256, ALPHA};
        pg8::gemm_phase<pg8::EpiRes, pg8::StaticOrder, true, true>(lds, g, S, E);
    } SEAM(16);
    if (IN(17)) for (int rep_ = 0; rep_ < kRep[17]; ++rep_) { phase_ln<false, false>(a, lds, Z, a.in[I_LNFG] + D, a.in[I_LNFB] + D, a.out, nullptr, 0, 0); }
#undef IN
#undef SEAM
}

extern "C" void kernel_launch(void* const* d_in, const int* in_sizes, int n_in, void* d_out, int out_size, void* d_ws, size_t ws_size, hipStream_t stream) {
    static int grid = 0;
    if (grid == 0) {
        if (n_in != 23 || ws_size < WS_END) { fprintf(stderr, "kernel_launch: need 23 inputs and %zu bytes of workspace; got %d, %zu\n", (size_t)WS_END, n_in, ws_size); grid = -1; return; }
        int dev = 0, cus = 0, per_cu = 0;
        hipGetDevice(&dev); hipDeviceGetAttribute(&cus, hipDeviceAttributeMultiprocessorCount, dev);
        if (hipFuncSetAttribute((const void*)mega, hipFuncAttributeMaxDynamicSharedMemorySize, LDS_BYTES) != hipSuccess) { fprintf(stderr, "kernel_launch: hipFuncSetAttribute failed\n"); grid = -1; return; }
        hipOccupancyMaxActiveBlocksPerMultiprocessor(&per_cu, (const void*)mega, NTHREADS, LDS_BYTES);
        (void)hipGetLastError();
        if (per_cu < 1) { fprintf(stderr, "kernel_launch: occupancy query says %d blocks per CU\n", per_cu); per_cu = 1; }
        grid = cus * per_cu;
    }
    if (grid < 0) return;
    Args a{};
    for (int i = 0; i < 23; ++i) a.in[i] = (const float*)d_in[i];
    a.out = (float*)d_out; a.ws = (unsigned char*)d_ws;
    if (hipMemsetAsync((char*)d_ws + WS_CTL, 0, 65536, stream) != hipSuccess) { fprintf(stderr, "kernel_launch: hipMemsetAsync failed\n"); return; }
    a.ph_lo = 0; a.ph_hi = 18;
    void* kargs[] = {&a};
    const hipError_t e = hipLaunchCooperativeKernel((const void*)mega, dim3(grid), dim3(NTHREADS), kargs, LDS_BYTES, stream);
    if (e != hipSuccess) fprintf(stderr, "kernel_launch: cooperative launch failed: %s (grid %d)\n", hipGetErrorString(e), grid);
}
```
